# Optimizing an MI355X kernel written in HIP

```python
import math
import jax, jax.numpy as jnp
from jax import lax
import numpy as np

D_MODEL = 2048
BATCH = 2
SEQ = 4096
DEPTH = 4

N_HEADS = 8
HEAD_DIM = 128
ATTN_W = N_HEADS * HEAD_DIM
MOBA_BLOCK = 256
MOBA_TOPK = 3
MOBA_QCHUNK = 64
N_BUCKETS = 32
MAX_DISTANCE = 128
LRU_W = D_MODEL // 2
LRU_BLOCKS = 8
LRU_BW = LRU_W // LRU_BLOCKS
LRU_CONV = 4
LRU_C = 8.0
SC_W = D_MODEL // 2
SC_CONV = 3
D_FF = 4 * D_MODEL
N_BRANCH = 3
EPS = 1e-6
IN_SPLITS = (ATTN_W, ATTN_W, ATTN_W, LRU_W, LRU_W, SC_W, SC_W, SC_W, N_BRANCH * D_MODEL)
N_IN = sum(IN_SPLITS)

kernel_name = "hybrid_moba_rglru_shortconv_trunk"


def rms_norm(x, g):
    xf = x.astype(jnp.float32)
    y = xf * lax.rsqrt(jnp.mean(xf * xf, axis=-1, keepdims=True) + EPS)
    return (y * g.astype(jnp.float32)).astype(x.dtype)


def causal_depthwise_conv(x, w):
    k = w.shape[0]
    return lax.conv_general_dilated(
        x, w[:, None, :].astype(x.dtype), window_strides=(1,), padding=[(k - 1, 0)],
        dimension_numbers=('NWC', 'WIO', 'NWC'), feature_group_count=x.shape[-1])


def t5_bucket(dist):
    n = jnp.maximum(dist, 0)
    max_exact = N_BUCKETS // 2
    nf = jnp.maximum(n, 1).astype(jnp.float32)
    large = max_exact + (jnp.log(nf / max_exact) / math.log(MAX_DISTANCE / max_exact)
                         * (N_BUCKETS - max_exact)).astype(jnp.int32)
    large = jnp.minimum(large, N_BUCKETS - 1)
    return jnp.where(n < max_exact, n, large)


def moba_attention(q, k, v, rel_table):
    bsz, seq, n_heads, d_head = q.shape
    n_blk = -(-seq // MOBA_BLOCK)
    s_pad = n_blk * MOBA_BLOCK
    topk = min(MOBA_TOPK, n_blk)
    pad = ((0, 0), (0, s_pad - seq), (0, 0), (0, 0))
    qh = jnp.pad(q * (d_head ** -0.5), pad).transpose(0, 2, 1, 3)
    kh = jnp.pad(k, pad).transpose(0, 2, 1, 3)
    vh = jnp.pad(v, pad).transpose(0, 2, 1, 3)
    kb = kh.reshape(bsz, n_heads, n_blk, MOBA_BLOCK, d_head)
    vb = vh.reshape(bsz, n_heads, n_blk, MOBA_BLOCK, d_head)
    k_mean = jnp.mean(kb.astype(jnp.float32), axis=3)
    gate = jnp.einsum('bhsd,bhnd->bhsn', qh.astype(jnp.float32), k_mean)
    q_blk = jnp.arange(s_pad) // MOBA_BLOCK
    past = jnp.arange(n_blk)[None, :] < q_blk[:, None]
    gate = jnp.where(past, gate, -jnp.inf)
    _, sel = lax.top_k(gate, topk)
    slot_ok = jnp.arange(topk)[None, :] < q_blk[:, None]
    b_idx = jnp.arange(bsz)[:, None, None, None]
    h_idx = jnp.arange(n_heads)[None, :, None, None]
    tbl_hb = rel_table.T
    blk_pos = jnp.arange(MOBA_BLOCK)

    def chunk(c):
        start = c * MOBA_QCHUNK
        qc = lax.dynamic_slice_in_dim(qh, start, MOBA_QCHUNK, axis=2)
        sel_c = lax.dynamic_slice_in_dim(sel, start, MOBA_QCHUNK, axis=2)
        ok_c = lax.dynamic_slice_in_dim(slot_ok, start, MOBA_QCHUNK, axis=0)
        q_pos = start + jnp.arange(MOBA_QCHUNK)
        kg = kb[b_idx, h_idx, sel_c]
        vg = vb[b_idx, h_idx, sel_c]
        s_past = jnp.einsum('bhqd,bhqnkd->bhqnk', qc, kg, preferred_element_type=jnp.float32)
        k_pos = sel_c[..., None] * MOBA_BLOCK + blk_pos
        bkt = t5_bucket(q_pos[:, None, None] - k_pos)
        s_past = s_past + tbl_hb[h_idx[..., None], bkt]
        s_past = jnp.where(ok_c[:, :, None], s_past, -jnp.inf)
        own = start // MOBA_BLOCK
        k_own = lax.dynamic_index_in_dim(kb, own, axis=2, keepdims=False)
        v_own = lax.dynamic_index_in_dim(vb, own, axis=2, keepdims=False)
        s_own = jnp.einsum('bhqd,bhkd->bhqk', qc, k_own, preferred_element_type=jnp.float32)
        dist = q_pos[:, None] - (own * MOBA_BLOCK + blk_pos)[None, :]
        s_own = s_own + rel_table[t5_bucket(dist)].transpose(2, 0, 1)
        s_own = jnp.where(dist >= 0, s_own, -jnp.inf)
        logits = jnp.concatenate(
            [s_past.reshape(bsz, n_heads, MOBA_QCHUNK, topk * MOBA_BLOCK), s_own], axis=-1)
        p = jax.nn.softmax(logits, axis=-1)
        p_past = p[..., :topk * MOBA_BLOCK].reshape(bsz, n_heads, MOBA_QCHUNK, topk, MOBA_BLOCK)
        p_own = p[..., topk * MOBA_BLOCK:]
        o = (jnp.einsum('bhqnk,bhqnkd->bhqd', p_past.astype(vg.dtype), vg,
                        preferred_element_type=jnp.float32)
             + jnp.einsum('bhqk,bhkd->bhqd', p_own.astype(v_own.dtype), v_own,
                          preferred_element_type=jnp.float32))
        return o.astype(q.dtype)

    out = lax.map(chunk, jnp.arange(s_pad // MOBA_QCHUNK))
    out = out.transpose(1, 0, 3, 2, 4).reshape(bsz, s_pad, n_heads * d_head)
    return out[:, :seq]


def _lru_combine(c1, c2):
    a1, b1 = c1
    a2, b2 = c2
    return a1 * a2, a2 * b1 + b2


def rg_lru_branch(xr, gate_br, conv_w, conv_b, wa, ba, wx, bx, lam):
    xc = causal_depthwise_conv(xr, conv_w) + conv_b
    bsz, seq, width = xc.shape
    xg = xc.reshape(bsz, seq, LRU_BLOCKS, LRU_BW)
    r = jax.nn.sigmoid((jnp.einsum('bsgi,gij->bsgj', xg, wa).reshape(bsz, seq, width) + ba)
                       .astype(jnp.float32))
    i = jax.nn.sigmoid((jnp.einsum('bsgi,gij->bsgj', xg, wx).reshape(bsz, seq, width) + bx)
                       .astype(jnp.float32))
    log_a = -LRU_C * r * jax.nn.softplus(-lam.astype(jnp.float32))
    a = jnp.exp(log_a)
    mult = jnp.sqrt(-jnp.expm1(2.0 * log_a))
    u = mult * i * xc.astype(jnp.float32)
    _, h = lax.associative_scan(_lru_combine, (a, u), axis=1)
    return (h * jax.nn.gelu(gate_br.astype(jnp.float32))).astype(xr.dtype)


def short_conv_branch(b, c, xs, conv_w):
    return b * causal_depthwise_conv(c * xs, conv_w)


def setup_inputs(seed: int = 0) -> dict:
    key = jax.random.key(seed)
    ks = jax.random.split(key, 24)
    f32 = jnp.float32
    nrm = lambda k, shape, fan_in: jax.random.normal(k, shape, f32) * (fan_in ** -0.5)
    u = jax.random.uniform(ks[12], (DEPTH, LRU_W), f32, minval=0.9, maxval=0.999)
    a_base = u ** (1.0 / LRU_C)
    lam = jnp.log(a_base) - jnp.log1p(-a_base)
    return {
        "x": jax.random.normal(ks[0], (BATCH, SEQ, D_MODEL), f32),
        "norm_mix_g": 1.0 + 0.02 * jax.random.normal(ks[1], (DEPTH, D_MODEL), f32),
        "w_in": nrm(ks[2], (DEPTH, D_MODEL, N_IN), D_MODEL),
        "gate_b": 0.02 * jax.random.normal(ks[3], (DEPTH, N_BRANCH * D_MODEL), f32),
        "rel_table": 0.1 * jax.random.normal(ks[4], (N_BUCKETS, N_HEADS), f32),
        "w_attn_o": nrm(ks[5], (DEPTH, ATTN_W, D_MODEL), ATTN_W),
        "lru_conv_w": nrm(ks[6], (DEPTH, LRU_CONV, LRU_W), LRU_CONV),
        "lru_conv_b": 0.02 * jax.random.normal(ks[7], (DEPTH, LRU_W), f32),
        "lru_wa": nrm(ks[8], (DEPTH, LRU_BLOCKS, LRU_BW, LRU_BW), LRU_BW),
        "lru_ba": 0.02 * jax.random.normal(ks[9], (DEPTH, LRU_W), f32),
        "lru_wx": nrm(ks[10], (DEPTH, LRU_BLOCKS, LRU_BW, LRU_BW), LRU_BW),
        "lru_bx": 0.02 * jax.random.normal(ks[11], (DEPTH, LRU_W), f32),
        "lru_lambda": lam,
        "w_lru_o": nrm(ks[13], (DEPTH, LRU_W, D_MODEL), LRU_W),
        "sc_conv_w": nrm(ks[14], (DEPTH, SC_CONV, SC_W), SC_CONV),
        "w_sc_o": nrm(ks[15], (DEPTH, SC_W, D_MODEL), SC_W),
        "w_out": nrm(ks[16], (DEPTH, D_MODEL, D_MODEL), D_MODEL),
        "norm_mlp_g": 1.0 + 0.02 * jax.random.normal(ks[17], (DEPTH, D_MODEL), f32),
        "w_mlp_up": nrm(ks[18], (DEPTH, D_MODEL, D_FF), D_MODEL),
        "w_mlp_down": nrm(ks[19], (DEPTH, D_FF, D_MODEL), D_FF),
        "final_g": 1.0 + 0.02 * jax.random.normal(ks[20], (D_MODEL,), f32),
    }


def reference(x, norm_mix_g, w_in, gate_b, rel_table, w_attn_o, lru_conv_w, lru_conv_b,
              lru_wa, lru_ba, lru_wx, lru_bx, lru_lambda, w_lru_o, sc_conv_w, w_sc_o,
              w_out, norm_mlp_g, w_mlp_up, w_mlp_down, final_g):
    bsz, seq, _ = x.shape
    offs = np.cumsum(IN_SPLITS)[:-1].tolist()
    for l in range(DEPTH):
        h = rms_norm(x, norm_mix_g[l])
        proj = h @ w_in[l]
        q, k, v, xr, gr, sc_b, sc_c, sc_x, g_pre = jnp.split(proj, offs, axis=-1)
        heads = (bsz, seq, N_HEADS, HEAD_DIM)
        y_a = moba_attention(q.reshape(heads), k.reshape(heads), v.reshape(heads),
                             rel_table) @ w_attn_o[l]
        y_b = rg_lru_branch(xr, gr, lru_conv_w[l], lru_conv_b[l], lru_wa[l], lru_ba[l],
                            lru_wx[l], lru_bx[l], lru_lambda[l]) @ w_lru_o[l]
        y_c = short_conv_branch(sc_b, sc_c, sc_x, sc_conv_w[l]) @ w_sc_o[l]
        g_a, g_b, g_c = jnp.split(jax.nn.sigmoid(g_pre + gate_b[l]), N_BRANCH, axis=-1)
        x = x + (g_a * y_a + g_b * y_b + g_c * y_c) @ w_out[l]
        h = rms_norm(x, norm_mlp_g[l])
        x = x + jnp.square(jax.nn.relu(h @ w_mlp_up[l])) @ w_mlp_down[l]
    return rms_norm(x, final_g)
```

```cpp
#include <hip/hip_runtime.h>
#include <cstdio>
#include <cstdint>

constexpr int D_MODEL = 2048, BATCH = 2, SEQ = 4096, DEPTH = 4;
constexpr int NH = 8, HD = 128, ATTN_W = NH * HD;
constexpr int MBLK = 256, TOPK = 3, NBLK = SEQ / MBLK;
constexpr int LRU_W = 1024, LRU_G = 8, LRU_BW = 128, SC_W = 1024;
constexpr int D_FF = 8192, N_IN = 14336, M_TOK = BATCH * SEQ;
constexpr float EPS = 1e-6f;
constexpr int SEG_Q = 0, SEG_K = 1, SEG_V = 2, SEG_XR = 3, SEG_GR = 4, SEG_SCB = 5, SEG_SCC = 6, SEG_SCX = 7;
constexpr int NGATE = 3 * D_MODEL;

constexpr size_t MiB = 1u << 20;
constexpr size_t WS_CTL = 0, CTL_ZERO_BYTES = 4 * MiB;
constexpr size_t CTL_KM = 1 * MiB;
constexpr size_t KM_LAYER_BYTES = (size_t)BATCH * NH * NBLK * HD * 4;
constexpr size_t WS_SSA = 4 * MiB, WS_SSB = 5 * MiB;
constexpr size_t WS_LRUS = 6 * MiB;
constexpr size_t WS_W = 8 * MiB;
constexpr size_t W_IN_B = (size_t)N_IN * D_MODEL * 2, W_ABC_B = (size_t)3 * D_MODEL * 1024 * 2, W_OUT_B = (size_t)D_MODEL * D_MODEL * 2, W_UP_B = (size_t)D_FF * D_MODEL * 2, W_DN_B = (size_t)D_MODEL * D_FF * 2;
constexpr size_t W_LAYER_B = W_IN_B + W_ABC_B + W_OUT_B + W_UP_B + W_DN_B;
constexpr size_t WS_XB = WS_W + DEPTH * W_LAYER_B;
constexpr size_t WS_SEG = WS_XB + (size_t)M_TOK * D_MODEL * 2;
constexpr size_t SEG_B = (size_t)M_TOK * 1024 * 2;
constexpr size_t WS_GATES = WS_SEG + 8 * SEG_B;
constexpr size_t WS_HID = WS_SEG;
constexpr size_t WS_ABC = WS_GATES + (size_t)M_TOK * NGATE * 2;
constexpr size_t WS_MB = WS_ABC + 3 * SEG_B;
constexpr size_t WS_END = WS_MB + (size_t)M_TOK * D_MODEL * 2;
static_assert(WS_HID + (size_t)M_TOK * D_FF * 2 <= WS_ABC, "hidden overlay");

#define GAS __attribute__((address_space(1)))
#define LAS __attribute__((address_space(3)))
typedef unsigned short bf16;
typedef unsigned v4u __attribute__((ext_vector_type(4)));
typedef unsigned v2u __attribute__((ext_vector_type(2)));
#define LDS_WAIT() asm volatile("s_waitcnt lgkmcnt(0)" ::: "memory")
#define VM_WAIT() asm volatile("s_waitcnt vmcnt(0)" ::: "memory")
__device__ __forceinline__ unsigned f2bf(float f) { unsigned u = __builtin_bit_cast(unsigned, f); return (u + 0x7fffu + ((u >> 16) & 1u)) >> 16; }
__device__ __forceinline__ unsigned pk2(float lo, float hi) { return f2bf(lo) | (f2bf(hi) << 16); }
__device__ __forceinline__ float bf2f(unsigned b) { return __builtin_bit_cast(float, b << 16); }
__device__ __forceinline__ float bflo(unsigned w) { return __builtin_bit_cast(float, w << 16); }
__device__ __forceinline__ float bfhi(unsigned w) { return __builtin_bit_cast(float, w & 0xffff0000u); }
__device__ __forceinline__ float bperm(float v, int src_lane) { return __builtin_bit_cast(float, __builtin_amdgcn_ds_bpermute(src_lane << 2, __builtin_bit_cast(int, v))); }
__device__ __forceinline__ float wave_sum(float v, int lane) {
#pragma unroll
    for (int o = 1; o < 64; o <<= 1) v += bperm(v, lane ^ o);
    return v;
}
__device__ __forceinline__ float fast_sigmoid(float x) { return __builtin_amdgcn_rcpf(1.f + __builtin_amdgcn_exp2f(-1.4426950408889634f * x)); }
__device__ __forceinline__ float sigmoidf_(float x) { return 1.f / (1.f + expf(-x)); }
__device__ __forceinline__ float gelu_tanh(float x) { return 0.5f * x * (1.f + tanhf(0.7978845608028654f * (x + 0.044715f * x * x * x))); }
__device__ __forceinline__ float row_rstd(const float* ss, int row) {
    typedef float f4 __attribute__((ext_vector_type(4)));
    const f4 a = *(const f4*)(ss + (size_t)row * 8), b = *(const f4*)(ss + (size_t)row * 8 + 4);
    const float s = ((a[0] + a[1]) + (a[2] + a[3])) + ((b[0] + b[1]) + (b[2] + b[3]));
    return rsqrtf(s * (1.f / D_MODEL) + EPS);
}
namespace pg8 {
#define PG8_LAS __attribute__((address_space(3)))
typedef unsigned short bf16_t;
typedef short bf16x8 __attribute__((ext_vector_type(8)));
typedef float f32x4 __attribute__((ext_vector_type(4)));
typedef unsigned u32x4 __attribute__((ext_vector_type(4)));
constexpr int BM = 256, BK = 64, HALF = 128, HTB = HALF * BK * 2  , STAGE_BYTES = 8 * HTB, NXCD = 8, WGM = 8;

__host__ __device__ __forceinline__ int lds_byte(int r, int c) { const int st = (r >> 4) * 2 + (c >> 5), rr = r & 15, cc = c & 31, ob = rr * 64 + cc * 2; return st * 1024 + (ob ^ (((ob >> 9) & 1) << 5)); }
__host__ __device__ __forceinline__ void stage_rc(int b, int& R, int& C) { const int st = b / 1024, sb = b % 1024, swz = sb ^ (((sb >> 9) & 1) << 5); R = (st >> 1) * 16 + swz / 64; C = (st & 1) * 32 + (swz % 64) / 2; }
__host__ __device__ __forceinline__ int perm32(int rho) { const int n = rho >> 4, i = rho & 15; return 8 * (i >> 2) + 4 * n + (i & 3); }

struct Unit { int pm, pn; };
struct Gemm { const bf16_t* A; const bf16_t* Bt; int M, N, K; };

struct StaticOrder {
    int nM, nN, nwg, G, c;
    __host__ __device__ void init(int M, int N, int G_, int c_) { nM = M / BM; nN = N / BM; nwg = nM * nN; G = G_; c = c_; }
    __host__ __device__ bool next(int i, Unit& u) const {
        const long L = (long)i * G + c; if (L >= nwg) return false;
        int wgid = (int)L; { const int q = nwg / NXCD, r = nwg % NXCD, xcd = wgid % NXCD, off = wgid / NXCD; wgid = (xcd < r ? xcd * (q + 1) : r * (q + 1) + (xcd - r) * q) + off; }
        const int nig = WGM * nN, gid = wgid / nig, fm = gid * WGM, gsz = (nM - fm) < WGM ? (nM - fm) : WGM;
        u.pm = fm + ((wgid % nig) % gsz); u.pn = (wgid % nig) / gsz; return true;
    }
    __device__ __forceinline__ void a_ready(const Unit&) const {}
    __device__ __forceinline__ void done(const Unit&) const {}
};
typedef float f32x2_t __attribute__((ext_vector_type(2))); typedef __bf16 bf16x2_t __attribute__((ext_vector_type(2)));
__device__ __forceinline__ unsigned cvt_pk_bf16(float lo, float hi) { f32x2_t v = {lo, hi}; bf16x2_t b = __builtin_convertvector(v, bf16x2_t); return __builtin_bit_cast(unsigned, b); }
typedef unsigned u32x2 __attribute__((ext_vector_type(2)));
__device__ __forceinline__ u32x4 pack8(const f32x4 v0, const f32x4 v1) { u32x4 w; w.x = cvt_pk_bf16(v0[0], v0[1]); w.y = cvt_pk_bf16(v0[2], v0[3]); w.z = cvt_pk_bf16(v1[0], v1[1]); w.w = cvt_pk_bf16(v1[2], v1[3]); return w; }
__device__ __forceinline__ void unpack8(const u32x4 w, f32x4& v0, f32x4& v1) {
    v0[0] = __builtin_bit_cast(float, w.x << 16); v0[1] = __builtin_bit_cast(float, w.x & 0xffff0000u); v0[2] = __builtin_bit_cast(float, w.y << 16); v0[3] = __builtin_bit_cast(float, w.y & 0xffff0000u);
    v1[0] = __builtin_bit_cast(float, w.z << 16); v1[1] = __builtin_bit_cast(float, w.z & 0xffff0000u); v1[2] = __builtin_bit_cast(float, w.w << 16); v1[3] = __builtin_bit_cast(float, w.w & 0xffff0000u);
}
__device__ __forceinline__ float rstd_of(const float* ss, int row) {
    const f32x4 a = *(const f32x4*)(ss + (size_t)row * 8), b = *(const f32x4*)(ss + (size_t)row * 8 + 4);
    const float s = ((a[0] + a[1]) + (a[2] + a[3])) + ((b[0] + b[1]) + (b[2] + b[3]));
    return __builtin_amdgcn_rsqf(s * (1.f / 2048.f) + 1e-6f);
}
__device__ __forceinline__ float sigm(float x) { return __builtin_amdgcn_rcpf(1.f + __builtin_amdgcn_exp2f(-1.4426950408889634f * x)); }

struct EpiProj {
    static constexpr bool PERM = true, AFTER_DRAIN = false, CHAIN = false;
    bf16_t* seg; bf16_t* gates; const PG8_LAS float* rs_lds; const float* gate_b; float* kmsum;
    __device__ __forceinline__ bool zero_after(const Unit&) const { return true; }
    __device__ __forceinline__ void operator()(const f32x4 (&acc)[2][2][4][2], const Unit& u, int wr, int wc, int fr, int fq) const {
        const int row0 = u.pm * BM + wr * 64 + fr;
        float rs[2][4];
#pragma unroll
        for (int ai = 0; ai < 2; ++ai)
#pragma unroll
            for (int m = 0; m < 4; ++m) rs[ai][m] = rs_lds[ai * HALF + wr * 64 + m * 16 + fr];
        if (u.pn < 32) {
            const int sg = u.pn >> 2, col0 = (u.pn & 3) * BM + wc * 32 + 8 * fq;
            bf16_t* base = seg + (size_t)sg * 8192 * 1024;
#pragma unroll
            for (int ai = 0; ai < 2; ++ai)
#pragma unroll
                for (int m = 0; m < 4; ++m) { bf16_t* rowp = base + (size_t)(row0 + ai * HALF + m * 16) * 1024 + col0; const float r = rs[ai][m];
#pragma unroll
                    for (int bj = 0; bj < 2; ++bj) *(u32x4*)(rowp + bj * HALF) = pack8(acc[ai][bj][m][0] * r, acc[ai][bj][m][1] * r); }
            if (sg == 1) {
                const int b = u.pm >> 4, blk = u.pm & 15;
#pragma unroll
                for (int bj = 0; bj < 2; ++bj)
#pragma unroll
                    for (int n = 0; n < 2; ++n) {
                        f32x4 s = (f32x4){0.f, 0.f, 0.f, 0.f};
#pragma unroll
                        for (int ai = 0; ai < 2; ++ai)
#pragma unroll
                            for (int m = 0; m < 4; ++m) s += acc[ai][bj][m][n] * rs[ai][m];
#pragma unroll
                        for (int j = 0; j < 4; ++j) { float v = s[j]; const int ln = fq * 16 + fr; v += bperm(v, ln ^ 1); v += bperm(v, ln ^ 2); v += bperm(v, ln ^ 4); v += bperm(v, ln ^ 8); s[j] = v; }
                        if (fr == 0) { const int c = col0 + bj * HALF + 4 * n; const int h = c >> 7, d = c & 127; float* p = kmsum + ((size_t)((b * 8 + h) * 16 + blk)) * 128 + d;
#pragma unroll
                            for (int j = 0; j < 4; ++j) atomicAdd(p + j, s[j]); }
                    }
            }
        } else {
            const int gcol0 = (u.pn - 32) * BM + wc * 32 + 8 * fq;
            constexpr float NL2E = -1.4426950408889634f, MAGIC = 8388608.f;
            f32x4 bv[2][2];
#pragma unroll
            for (int bj = 0; bj < 2; ++bj)
#pragma unroll
                for (int n = 0; n < 2; ++n) bv[bj][n] = *(const f32x4*)(gate_b + gcol0 + bj * HALF + 4 * n) * NL2E;
#pragma unroll
            for (int ai = 0; ai < 2; ++ai)
#pragma unroll
                for (int m = 0; m < 4; ++m) { unsigned char* rowp = (unsigned char*)gates + (size_t)(row0 + ai * HALF + m * 16) * 6144 + gcol0; const float r = rs[ai][m] * NL2E;
#pragma unroll
                    for (int bj = 0; bj < 2; ++bj) { u32x2 w;
#pragma unroll
                        for (int n = 0; n < 2; ++n) { const f32x4 t = acc[ai][bj][m][n] * r + bv[bj][n]; f32x4 e, z;
#pragma unroll
                            for (int j = 0; j < 4; ++j) e[j] = __builtin_amdgcn_exp2f(t[j]);
                            const f32x4 y = e * (1.f / 256.f) + (1.f / 256.f);
#pragma unroll
                            for (int j = 0; j < 4; ++j) z[j] = __builtin_amdgcn_rcpf(y[j]);
                            const f32x4 s = z + MAGIC; unsigned qb[4];
#pragma unroll
                            for (int j = 0; j < 4; ++j) qb[j] = __builtin_bit_cast(unsigned, __builtin_amdgcn_fmed3f(s[j], MAGIC + 1.f, MAGIC + 255.f));
                            const unsigned lo = __builtin_amdgcn_perm(qb[1], qb[0], 0x0c0c0400u), hi = __builtin_amdgcn_perm(qb[3], qb[2], 0x0c0c0400u);
                            w[n] = __builtin_amdgcn_perm(hi, lo, 0x05040100u); }
                        *(u32x2*)(rowp + bj * HALF) = w; } }
        }
    }
};

struct EpiMerge {
    static constexpr bool PERM = true, AFTER_DRAIN = false, CHAIN = true;
    const unsigned char* gates; bf16_t* mb;
    __device__ __forceinline__ bool zero_after(const Unit& u) const { return (u.pm >> 5) == 2; }
    __device__ __forceinline__ static void unq(const u32x2 w, f32x4& g0, f32x4& g1) {
        g0[0] = (float)(w.x & 0xffu); g0[1] = (float)((w.x >> 8) & 0xffu); g0[2] = (float)((w.x >> 16) & 0xffu); g0[3] = (float)(w.x >> 24);
        g1[0] = (float)(w.y & 0xffu); g1[1] = (float)((w.y >> 8) & 0xffu); g1[2] = (float)((w.y >> 16) & 0xffu); g1[3] = (float)(w.y >> 24); }
    __device__ __forceinline__ void operator()(f32x4 (&acc)[2][2][4][2], const Unit& u, int wr, int wc, int fr, int fq) const {
        const int br = u.pm >> 5, pm = u.pm & 31, pn = u.pn & 7;
        const int row0 = pm * BM + wr * 64 + fr, col0 = pn * BM + wc * 32 + 8 * fq;
#pragma unroll
        for (int ai = 0; ai < 2; ++ai)
#pragma unroll
            for (int m = 0; m < 4; ++m) { const size_t r = (size_t)(row0 + ai * HALF + m * 16);
#pragma unroll
                for (int bj = 0; bj < 2; ++bj) {
                    const unsigned char* gp = gates + r * 6144 + br * 2048 + col0 + bj * HALF;
                    f32x4 g0, g1; unq(*(const u32x2*)gp, g0, g1);
                    if (br < 2) { f32x4 h0, h1; unq(*(const u32x2*)(gp + 2048), h0, h1);
#pragma unroll
                        for (int j = 0; j < 4; ++j) { g0[j] *= __builtin_amdgcn_rcpf(h0[j]); g1[j] *= __builtin_amdgcn_rcpf(h1[j]); }
                        acc[ai][bj][m][0] *= g0; acc[ai][bj][m][1] *= g1;
                    } else *(u32x4*)(mb + r * 2048 + col0 + bj * HALF) = pack8(acc[ai][bj][m][0] * (g0 * (1.f / 256.f)), acc[ai][bj][m][1] * (g1 * (1.f / 256.f)));
                } }
    }
};

struct EpiResid {
    static constexpr bool PERM = true, AFTER_DRAIN = true, CHAIN = false;
    bf16_t* xb; float* ssq;
    __device__ __forceinline__ bool zero_after(const Unit&) const { return true; }
    __device__ __forceinline__ void fused(f32x4 (&acc)[2][2][4][2], const Unit& u, int wr, int wc, int fr, int fq, PG8_LAS unsigned char* lds, int wid, int lane) const {
        PG8_LAS float* P = (PG8_LAS float*)lds;
        const int row0 = u.pm * BM + wr * 64 + fr, col0 = u.pn * BM + wc * 32 + 8 * fq;
#pragma unroll
        for (int ai = 0; ai < 2; ++ai)
#pragma unroll
            for (int m = 0; m < 4; ++m) { const int rl = ai * HALF + wr * 64 + m * 16 + fr; const size_t off = (size_t)(row0 + ai * HALF + m * 16) * 2048 + col0; float q = 0.f;
#pragma unroll
                for (int bj = 0; bj < 2; ++bj) { bf16_t* p = xb + off + bj * HALF; f32x4 o0, o1; unpack8(*(const u32x4*)p, o0, o1); const f32x4 v0 = o0 + acc[ai][bj][m][0], v1 = o1 + acc[ai][bj][m][1];
                    *(u32x4*)p = pack8(v0, v1);
                    q += (v0[0] * v0[0] + v0[1] * v0[1]) + (v0[2] * v0[2] + v0[3] * v0[3]) + (v1[0] * v1[0] + v1[1] * v1[1]) + (v1[2] * v1[2] + v1[3] * v1[3]); }
                q += bperm(q, lane ^ 16); q += bperm(q, lane ^ 32);
                if (fq == 0) P[rl * 4 + wc] = q; }
        asm volatile("s_waitcnt lgkmcnt(0)" ::: "memory"); __builtin_amdgcn_s_barrier(); asm volatile("" ::: "memory");
        const int t = wid * 64 + lane;
        if (t < 256) { const f32x4 p = *(const PG8_LAS f32x4*)(P + t * 4); ssq[(size_t)(u.pm * BM + t) * 8 + u.pn] = (p[0] + p[1]) + (p[2] + p[3]); }
    }
};

struct EpiResidFin {
    static constexpr bool PERM = true, AFTER_DRAIN = true, CHAIN = false;
    const bf16_t* xb; float* part; unsigned* cnt; const float* fg; float* out;
    __device__ __forceinline__ bool zero_after(const Unit&) const { return true; }
    __device__ __forceinline__ void fused(f32x4 (&acc)[2][2][4][2], const Unit& u, int wr, int wc, int fr, int fq, PG8_LAS unsigned char* lds, int wid, int lane) const {
        PG8_LAS float* P = (PG8_LAS float*)lds;
        PG8_LAS float* RS = (PG8_LAS float*)(lds + 4096);
        const int row0 = u.pm * BM + wr * 64 + fr, col0 = u.pn * BM + wc * 32 + 8 * fq;
#pragma unroll
        for (int ai = 0; ai < 2; ++ai)
#pragma unroll
            for (int m = 0; m < 4; ++m) { const int rl = ai * HALF + wr * 64 + m * 16 + fr; const size_t off = (size_t)(row0 + ai * HALF + m * 16) * 2048 + col0; float q = 0.f;
#pragma unroll
                for (int bj = 0; bj < 2; ++bj) { f32x4 o0, o1; unpack8(*(const u32x4*)(xb + off + bj * HALF), o0, o1); const f32x4 v0 = o0 + acc[ai][bj][m][0], v1 = o1 + acc[ai][bj][m][1];
                    acc[ai][bj][m][0] = v0; acc[ai][bj][m][1] = v1;
                    q += (v0[0] * v0[0] + v0[1] * v0[1]) + (v0[2] * v0[2] + v0[3] * v0[3]) + (v1[0] * v1[0] + v1[1] * v1[1]) + (v1[2] * v1[2] + v1[3] * v1[3]); }
                q += bperm(q, lane ^ 16); q += bperm(q, lane ^ 32);
                if (fq == 0) P[rl * 4 + wc] = q; }
        asm volatile("s_waitcnt lgkmcnt(0)" ::: "memory"); __builtin_amdgcn_s_barrier(); asm volatile("" ::: "memory");
        const int t = wid * 64 + lane;
        if (t < 256) { const f32x4 p = *(const PG8_LAS f32x4*)(P + t * 4); __hip_atomic_store(part + (size_t)(u.pm * BM + t) * 8 + u.pn, (p[0] + p[1]) + (p[2] + p[3]), __ATOMIC_RELAXED, __HIP_MEMORY_SCOPE_AGENT); }
        asm volatile("s_waitcnt vmcnt(0) lgkmcnt(0)" ::: "memory"); __builtin_amdgcn_s_barrier(); asm volatile("" ::: "memory");
        if (wid == 0) {
            if (lane == 0) { __hip_atomic_fetch_add(cnt + u.pm, 1u, __ATOMIC_RELAXED, __HIP_MEMORY_SCOPE_AGENT); unsigned spins = 0;
                while (__hip_atomic_load(cnt + u.pm, __ATOMIC_RELAXED, __HIP_MEMORY_SCOPE_AGENT) < 8u) { __builtin_amdgcn_s_sleep(2); if (++spins > (1u << 22)) break; } }
            __builtin_amdgcn_fence(__ATOMIC_ACQUIRE, "agent");
            asm volatile("s_waitcnt vmcnt(0)" ::: "memory");
        }
        asm volatile("s_waitcnt vmcnt(0) lgkmcnt(0)" ::: "memory"); __builtin_amdgcn_s_barrier(); asm volatile("" ::: "memory");
        if (t < 256) { float s = 0.f;
#pragma unroll
            for (int j = 0; j < 8; ++j) s += __hip_atomic_load(part + (size_t)(u.pm * BM + t) * 8 + j, __ATOMIC_RELAXED, __HIP_MEMORY_SCOPE_AGENT);
            RS[t] = __builtin_amdgcn_rsqf(s * (1.f / 2048.f) + 1e-6f); }
        asm volatile("s_waitcnt vmcnt(0) lgkmcnt(0)" ::: "memory"); __builtin_amdgcn_s_barrier(); asm volatile("" ::: "memory");
        f32x4 gv[2][2];
#pragma unroll
        for (int bj = 0; bj < 2; ++bj)
#pragma unroll
            for (int n = 0; n < 2; ++n) gv[bj][n] = *(const f32x4*)(fg + col0 + bj * HALF + 4 * n);
#pragma unroll
        for (int ai = 0; ai < 2; ++ai)
#pragma unroll
            for (int m = 0; m < 4; ++m) { const float r = RS[ai * HALF + wr * 64 + m * 16 + fr]; float* orow = out + (size_t)(row0 + ai * HALF + m * 16) * 2048 + col0;
#pragma unroll
                for (int bj = 0; bj < 2; ++bj) { *(f32x4*)(orow + bj * HALF) = acc[ai][bj][m][0] * r * gv[bj][0]; *(f32x4*)(orow + bj * HALF + 4) = acc[ai][bj][m][1] * r * gv[bj][1]; } }
    }
};

struct EpiUp {
    static constexpr bool PERM = true, AFTER_DRAIN = false, CHAIN = false;
    bf16_t* hid; const PG8_LAS float* rs_lds;
    __device__ __forceinline__ bool zero_after(const Unit&) const { return true; }
    __device__ __forceinline__ void operator()(const f32x4 (&acc)[2][2][4][2], const Unit& u, int wr, int wc, int fr, int fq) const {
        const int row0 = u.pm * BM + wr * 64 + fr, col0 = u.pn * BM + wc * 32 + 8 * fq;
#pragma unroll
        for (int ai = 0; ai < 2; ++ai)
#pragma unroll
            for (int m = 0; m < 4; ++m) { const int row = row0 + ai * HALF + m * 16; const float r = rs_lds[ai * HALF + wr * 64 + m * 16 + fr]; bf16_t* rowp = hid + (size_t)row * 8192 + col0;
#pragma unroll
                for (int bj = 0; bj < 2; ++bj) { f32x4 v0 = acc[ai][bj][m][0] * r, v1 = acc[ai][bj][m][1] * r;
#pragma unroll
                    for (int j = 0; j < 4; ++j) { const float a = fmaxf(v0[j], 0.f), b = fmaxf(v1[j], 0.f); v0[j] = a * a; v1[j] = b * b; }
                    *(u32x4*)(rowp + bj * HALF) = pack8(v0, v1); } }
    }
};

struct MergeOrder {
    StaticOrder base;
    __device__ void init(int G, int c) { base.init(8192, 2048, G, c); }
    __device__ bool next(int i, Unit& u) const { Unit t; if (!base.next(i / 3, t)) return false; const int br = i % 3; u.pm = br * 32 + t.pm; u.pn = br * 8 + t.pn; return true; }
    __device__ __forceinline__ void a_ready(const Unit&) const {}
    __device__ __forceinline__ void done(const Unit&) const {}
};
template <class Epi, class Sched, bool ALIGN_EPI = false, bool SP2 = false>
__device__ __forceinline__ void gemm_phase(PG8_LAS unsigned char* lds, const Gemm g, const Sched& S, const Epi& E, int tid_in) {
    int tid_l = tid_in; asm volatile("" : "+v"(tid_l));
    const int tid = tid_l, wid = __builtin_amdgcn_readfirstlane(tid >> 6), lane = tid & 63, wr = wid >> 2, wc = wid & 3, fr = lane & 15, fq = lane >> 4;
    const int K = g.K, nt = K / BK;
    unsigned voffA[2], voffB[2];
#pragma unroll
    for (int i = 0; i < 2; ++i) { int R, C; stage_rc(tid * 16 + i * 8192, R, C); const int Rb = Epi::PERM ? ((R & ~31) + perm32(R & 31)) : R;
        voffA[i] = (unsigned)(R * K + C) * 2u; voffB[i] = (unsigned)(Rb * K + C) * 2u; }
    const size_t kstep = (size_t)(BK * 2);
    const size_t hstep = (size_t)HALF * K * 2;
    const size_t tstep = 2 * hstep;
    const unsigned ldsw = (unsigned)wid * 1024u;
    const int aoff = lds_byte(wr * 64 + fr, fq * 8), boff = lds_byte(wc * 32 + fr, fq * 8);
#define PG8_SA(b, h) (((b) * 2 + (h)) * HTB)
#define PG8_SB(b, h) ((4 + (b) * 2 + (h)) * HTB)
#define PG8_STAGE(bufoff, gbase, voff) do { _Pragma("unroll") for (int _i = 0; _i < 2; ++_i) \
        __builtin_amdgcn_global_load_lds((const unsigned*)((const char*)(gbase) + (voff)[_i]), (PG8_LAS unsigned*)(lds + (bufoff) + ldsw + _i * 8192), 16, 0, 0); } while (0)
#define PG8_LDA(dst, b, h) do { _Pragma("unroll") for (int m = 0; m < 4; ++m) _Pragma("unroll") for (int k = 0; k < 2; ++k) dst[m][k] = *(const PG8_LAS bf16x8*)(lds + PG8_SA(b, h) + aoff + m * 2048 + k * 1024); } while (0)
#define PG8_LDB(dst, b, h) do { _Pragma("unroll") for (int n = 0; n < 2; ++n) _Pragma("unroll") for (int k = 0; k < 2; ++k) dst[n][k] = *(const PG8_LAS bf16x8*)(lds + PG8_SB(b, h) + boff + n * 2048 + k * 1024); } while (0)
#define PG8_MMA(ai, bj, At, Bt) do { __builtin_amdgcn_s_setprio(1); _Pragma("unroll") for (int m = 0; m < 4; ++m) _Pragma("unroll") for (int n = 0; n < 2; ++n) _Pragma("unroll") for (int k = 0; k < 2; ++k) \
        acc[ai][bj][m][n] = __builtin_amdgcn_mfma_f32_16x16x32_bf16(Bt[n][k], At[m][k], acc[ai][bj][m][n], 0, 0, 0); __builtin_amdgcn_s_setprio(0); } while (0)
#define PG8_WAIT_V(n) asm volatile("s_waitcnt vmcnt(" #n ")" ::: "memory")
#define PG8_WAIT_L(n) asm volatile("s_waitcnt lgkmcnt(" #n ")" ::: "memory")
#define PG8_BAR __builtin_amdgcn_s_barrier()
#define PG8_SCHED __builtin_amdgcn_sched_barrier(0)
    Unit cur, nxt; int ui = 0;
    if (!S.next(0, cur)) return;
    f32x4 acc[2][2][4][2];
#pragma unroll
    for (int a = 0; a < 2; ++a)
#pragma unroll
        for (int b = 0; b < 2; ++b)
#pragma unroll
            for (int m = 0; m < 4; ++m)
#pragma unroll
                for (int n = 0; n < 2; ++n) acc[a][b][m][n] = (f32x4){0.f, 0.f, 0.f, 0.f};
    bf16x8 At[4][2], B0[2][2], B1[2][2];
    const char* cA = (const char*)g.A + (size_t)cur.pm * tstep; const char* cB = (const char*)g.Bt + (size_t)cur.pn * tstep;
    S.a_ready(cur);
    if constexpr (SP2) {
        PG8_STAGE(PG8_SB(0, 0), cB, voffB); PG8_STAGE(PG8_SB(0, 1), cB + hstep, voffB); PG8_STAGE(PG8_SA(0, 0), cA, voffA); PG8_STAGE(PG8_SA(0, 1), cA + hstep, voffA);
        if (wr == 1) PG8_BAR;
        PG8_WAIT_V(2); PG8_BAR;
        PG8_STAGE(PG8_SB(1, 0), cB + kstep, voffB); PG8_STAGE(PG8_SA(1, 0), cA + kstep, voffA); PG8_STAGE(PG8_SB(1, 1), cB + hstep + kstep, voffB);
        PG8_WAIT_V(6); PG8_BAR;
    } else {
        PG8_STAGE(PG8_SB(0, 0), cB, voffB); PG8_STAGE(PG8_SA(0, 0), cA, voffA); PG8_STAGE(PG8_SB(0, 1), cB + hstep, voffB); PG8_STAGE(PG8_SA(0, 1), cA + hstep, voffA);
        if (wr == 1) PG8_BAR;
        PG8_WAIT_V(4); PG8_BAR;
        PG8_STAGE(PG8_SB(1, 0), cB + kstep, voffB); PG8_STAGE(PG8_SA(1, 0), cA + kstep, voffA); PG8_STAGE(PG8_SB(1, 1), cB + hstep + kstep, voffB);
        PG8_WAIT_V(6); PG8_BAR;
    }
    for (;;) {
        const bool has_next = S.next(ui + 1, nxt);
        const char* nA = has_next ? (const char*)g.A + (size_t)nxt.pm * tstep : cA; const char* nB = has_next ? (const char*)g.Bt + (size_t)nxt.pn * tstep : cB;
        for (int t = 0; t < nt; t += 2) {
            const bool last = (t == nt - 2);
            const char* a1 = cA + (size_t)(t + 1) * kstep;
            const char* a2 = last ? nA : cA + (size_t)(t + 2) * kstep; const char* b2 = last ? nB : cB + (size_t)(t + 2) * kstep;
            const char* a3 = a2 + kstep; const char* b3 = b2 + kstep;
            if (last && has_next) S.a_ready(nxt);
            if constexpr (SP2) {
            PG8_LDB(B0, 0, 0); PG8_LDB(B1, 0, 1); PG8_SCHED; PG8_LDA(At, 0, 0); PG8_STAGE(PG8_SA(1, 1), a1 + hstep, voffA);
            PG8_WAIT_V(8); PG8_WAIT_L(0); PG8_BAR; PG8_MMA(0, 0, At, B0); PG8_MMA(0, 1, At, B1); PG8_BAR; PG8_SCHED;
            PG8_LDA(At, 0, 1); PG8_STAGE(PG8_SB(0, 0), b2, voffB); PG8_STAGE(PG8_SB(0, 1), b2 + hstep, voffB); PG8_STAGE(PG8_SA(0, 0), a2, voffA);
            PG8_WAIT_V(8); PG8_WAIT_L(0); PG8_BAR; PG8_MMA(1, 0, At, B0); PG8_MMA(1, 1, At, B1); PG8_BAR; PG8_SCHED;
            PG8_LDB(B0, 1, 0); PG8_LDB(B1, 1, 1); PG8_SCHED; PG8_LDA(At, 1, 0); PG8_STAGE(PG8_SA(0, 1), a2 + hstep, voffA);
            PG8_WAIT_V(8); PG8_WAIT_L(0); PG8_BAR; PG8_MMA(0, 0, At, B0); PG8_MMA(0, 1, At, B1); PG8_BAR; PG8_SCHED;
            PG8_LDA(At, 1, 1); PG8_STAGE(PG8_SB(1, 0), b3, voffB); PG8_STAGE(PG8_SB(1, 1), b3 + hstep, voffB); PG8_STAGE(PG8_SA(1, 0), a3, voffA);
            PG8_WAIT_V(8); PG8_WAIT_L(0); PG8_BAR; PG8_MMA(1, 0, At, B0); PG8_MMA(1, 1, At, B1); PG8_BAR; PG8_SCHED;
            } else {
            PG8_LDB(B0, 0, 0); PG8_SCHED; PG8_LDA(At, 0, 0); PG8_STAGE(PG8_SA(1, 1), a1 + hstep, voffA);
            PG8_WAIT_L(8); PG8_BAR; PG8_WAIT_L(0); PG8_MMA(0, 0, At, B0); PG8_BAR; PG8_SCHED;
            PG8_LDB(B1, 0, 1); PG8_STAGE(PG8_SB(0, 0), b2, voffB);
            PG8_BAR; PG8_WAIT_L(0); PG8_MMA(0, 1, At, B1); PG8_BAR;
            PG8_LDA(At, 0, 1); PG8_STAGE(PG8_SA(0, 0), a2, voffA);
            PG8_BAR; PG8_WAIT_L(0); PG8_MMA(1, 0, At, B0); PG8_BAR; PG8_SCHED;
            PG8_STAGE(PG8_SB(0, 1), b2 + hstep, voffB);
            PG8_WAIT_V(6); PG8_BAR; PG8_MMA(1, 1, At, B1); PG8_BAR;
            PG8_LDB(B0, 1, 0); PG8_SCHED; PG8_LDA(At, 1, 0); PG8_STAGE(PG8_SA(0, 1), a2 + hstep, voffA);
            PG8_WAIT_L(8); PG8_BAR; PG8_WAIT_L(0); PG8_MMA(0, 0, At, B0); PG8_BAR; PG8_SCHED;
            PG8_LDB(B1, 1, 1); PG8_STAGE(PG8_SB(1, 0), b3, voffB);
            PG8_BAR; PG8_WAIT_L(0); PG8_MMA(0, 1, At, B1); PG8_BAR;
            PG8_LDA(At, 1, 1); PG8_STAGE(PG8_SA(1, 0), a3, voffA);
            PG8_BAR; PG8_WAIT_L(0); PG8_MMA(1, 0, At, B0); PG8_BAR; PG8_SCHED;
            PG8_STAGE(PG8_SB(1, 1), b3 + hstep, voffB);
            PG8_WAIT_V(6); PG8_BAR; PG8_MMA(1, 1, At, B1); PG8_BAR;
            }
        }
        if constexpr (ALIGN_EPI) { if (wr == 0) PG8_BAR; }
        if constexpr (!Epi::AFTER_DRAIN) { E(acc, cur, wr, wc, fr, fq); S.done(cur); }
        if (!has_next) break;
        if (!Epi::CHAIN || E.zero_after(cur)) {
#pragma unroll
        for (int a = 0; a < 2; ++a)
#pragma unroll
            for (int b = 0; b < 2; ++b)
#pragma unroll
                for (int m = 0; m < 4; ++m)
#pragma unroll
                    for (int n = 0; n < 2; ++n) acc[a][b][m][n] = (f32x4){0.f, 0.f, 0.f, 0.f};
        }
        cur = nxt; cA = nA; cB = nB; ++ui;
        if constexpr (ALIGN_EPI) { if (wr == 1) PG8_BAR; }
    }
    PG8_WAIT_V(0);
    if constexpr (!ALIGN_EPI) { if (wr == 0) PG8_BAR; }
    PG8_BAR;
    if constexpr (Epi::AFTER_DRAIN) { E.fused(acc, cur, wr, wc, fr, fq, lds, wid, lane); S.done(cur); }
#undef PG8_SA
#undef PG8_SB
#undef PG8_STAGE
#undef PG8_LDA
#undef PG8_LDB
#undef PG8_MMA
#undef PG8_WAIT_V
#undef PG8_WAIT_L
#undef PG8_BAR
#undef PG8_SCHED
}
}

constexpr int RING_OFF = 0, RING_BYTES = 131072;
constexpr int LDS_BYTES = 151552;
constexpr int MISC_OFF = LDS_BYTES - 256;
constexpr int NWAVES = 8;

struct Args { const float* in[21]; float* out; unsigned char* ws; int l; int pad; };

struct Ctx {
    LAS unsigned char* lds;
    int tid, lane, wave, G, bid;
    const float* in[21]; float* out; unsigned char* ws;
    __device__ __forceinline__ bf16* w_in_t(int l) const { return (bf16*)(ws + WS_W + (size_t)l * W_LAYER_B); }
    __device__ __forceinline__ bf16* w_abc_t(int l) const { return (bf16*)(ws + WS_W + (size_t)l * W_LAYER_B + W_IN_B); }
    __device__ __forceinline__ bf16* w_out_t(int l) const { return (bf16*)(ws + WS_W + (size_t)l * W_LAYER_B + W_IN_B + W_ABC_B); }
    __device__ __forceinline__ bf16* w_up_t(int l) const { return (bf16*)(ws + WS_W + (size_t)l * W_LAYER_B + W_IN_B + W_ABC_B + W_OUT_B); }
    __device__ __forceinline__ bf16* w_dn_t(int l) const { return (bf16*)(ws + WS_W + (size_t)l * W_LAYER_B + W_IN_B + W_ABC_B + W_OUT_B + W_UP_B); }
    __device__ __forceinline__ bf16* xb() const { return (bf16*)(ws + WS_XB); }
    __device__ __forceinline__ bf16* seg(int s) const { return (bf16*)(ws + WS_SEG + (size_t)s * SEG_B); }
    __device__ __forceinline__ bf16* gates() const { return (bf16*)(ws + WS_GATES); }
    __device__ __forceinline__ bf16* hid() const { return (bf16*)(ws + WS_HID); }
    __device__ __forceinline__ bf16* abc(int b) const { return (bf16*)(ws + WS_ABC + (size_t)b * SEG_B); }
    __device__ __forceinline__ bf16* mb() const { return (bf16*)(ws + WS_MB); }
    __device__ __forceinline__ float* ssa() const { return (float*)(ws + WS_SSA); }
    __device__ __forceinline__ float* ssb() const { return (float*)(ws + WS_SSB); }
    __device__ __forceinline__ float* kmsum(int l) const { return (float*)(ws + WS_CTL + CTL_KM + (size_t)l * KM_LAYER_BYTES); }
};

__device__ __forceinline__ void relaunder(Ctx& C) { int w = C.wave; asm volatile("" : "+s"(w)); int ln = (int)__builtin_amdgcn_mbcnt_hi(~0u, __builtin_amdgcn_mbcnt_lo(~0u, 0u)); asm volatile("" : "+v"(ln)); C.wave = w; C.lane = ln; C.tid = w * 64 + ln; }
constexpr int TR_PITCH = 65, TR_WAVE_BYTES = 64 * TR_PITCH * 4;
static_assert(8 * TR_WAVE_BYTES <= MISC_OFF, "transpose scratch below the control words");
__device__ __forceinline__ unsigned cvt2(float lo, float hi) { typedef float f2 __attribute__((ext_vector_type(2))); typedef __bf16 b2 __attribute__((ext_vector_type(2))); f2 v = {lo, hi}; b2 b = __builtin_convertvector(v, b2); return __builtin_bit_cast(unsigned, b); }
typedef float f4_t __attribute__((ext_vector_type(4)));
__device__ __forceinline__ void ti_load(f4_t (&v)[16], const float* __restrict__ W, int K, int N, int item, int lane) {
    const int kblk = K / 64, nb = item / kblk, kb = item % kblk, k0 = 64 * kb, n0 = 64 * nb;
    const int r = lane >> 4, q = lane & 15;
#pragma unroll
    for (int i = 0; i < 16; ++i) v[i] = *(const f4_t*)(W + (size_t)(k0 + 4 * i + r) * N + n0 + 4 * q);
}
__device__ __forceinline__ void ti_finish(f4_t (&v)[16], const float* __restrict__ gain, int K, int N, bf16* WT, int row_off, LAS float* scr, int item, int lane) {
    const int kblk = K / 64, nb = item / kblk, kb = item % kblk, k0 = 64 * kb, n0 = 64 * nb;
    const int r = lane >> 4, q = lane & 15;
    if (gain) {
#pragma unroll
        for (int i = 0; i < 16; ++i) v[i] *= gain[k0 + 4 * i + r];
    }
#pragma unroll
    for (int i = 0; i < 16; ++i) { LAS float* d = scr + (4 * i + r) * TR_PITCH + 4 * q; d[0] = v[i][0]; d[1] = v[i][1]; d[2] = v[i][2]; d[3] = v[i][3]; }
    LDS_WAIT(); asm volatile("" ::: "memory");
    const int c = lane & 7;
#pragma unroll
    for (int j = 0; j < 8; ++j) { const int n = (lane >> 3) + 8 * j; const LAS float* s = scr + (8 * c) * TR_PITCH + n;
        v4u o; o.x = cvt2(s[0 * TR_PITCH], s[1 * TR_PITCH]); o.y = cvt2(s[2 * TR_PITCH], s[3 * TR_PITCH]); o.z = cvt2(s[4 * TR_PITCH], s[5 * TR_PITCH]); o.w = cvt2(s[6 * TR_PITCH], s[7 * TR_PITCH]);
        *(v4u*)(WT + (size_t)(row_off + n0 + n) * K + k0 + 8 * c) = o; }
    LDS_WAIT(); asm volatile("" ::: "memory");
}
constexpr int I_IN = (D_MODEL / 64) * (N_IN / 64), I_B = (1024 / 64) * (D_MODEL / 64), I_OUT = (D_MODEL / 64) * (D_MODEL / 64), I_UP = (D_MODEL / 64) * (D_FF / 64), I_DN = (D_FF / 64) * (D_MODEL / 64);
constexpr int NIT = I_IN + 3 * I_B + I_OUT + I_UP + I_DN;
static_assert(NIT == 512 * 35, "the attention phase deals exactly 35 items to every 64 idle wave-tiles");
__device__ __forceinline__ void conv_load(const Ctx& C, int l, int r, f4_t (&v)[16], int lane) {
    if (r < I_IN) { ti_load(v, C.in[2] + (size_t)l * D_MODEL * N_IN, D_MODEL, N_IN, r, lane); return; } r -= I_IN;
    if (r < I_B) { ti_load(v, C.in[5] + (size_t)l * 1024 * D_MODEL, 1024, D_MODEL, r, lane); return; } r -= I_B;
    if (r < I_B) { ti_load(v, C.in[13] + (size_t)l * 1024 * D_MODEL, 1024, D_MODEL, r, lane); return; } r -= I_B;
    if (r < I_B) { ti_load(v, C.in[15] + (size_t)l * 1024 * D_MODEL, 1024, D_MODEL, r, lane); return; } r -= I_B;
    if (r < I_OUT) { ti_load(v, C.in[16] + (size_t)l * D_MODEL * D_MODEL, D_MODEL, D_MODEL, r, lane); return; } r -= I_OUT;
    if (r < I_UP) { ti_load(v, C.in[18] + (size_t)l * D_MODEL * D_FF, D_MODEL, D_FF, r, lane); return; } r -= I_UP;
    ti_load(v, C.in[19] + (size_t)l * D_FF * D_MODEL, D_FF, D_MODEL, r, lane);
}
__device__ __forceinline__ void conv_finish(const Ctx& C, int l, int r, f4_t (&v)[16], LAS float* scr, int lane) {
    if (r < I_IN) { ti_finish(v, C.in[1] + (size_t)l * D_MODEL, D_MODEL, N_IN, C.w_in_t(l), 0, scr, r, lane); return; } r -= I_IN;
    if (r < I_B) { ti_finish(v, nullptr, 1024, D_MODEL, C.w_abc_t(l), 0, scr, r, lane); return; } r -= I_B;
    if (r < I_B) { ti_finish(v, nullptr, 1024, D_MODEL, C.w_abc_t(l), 2048, scr, r, lane); return; } r -= I_B;
    if (r < I_B) { ti_finish(v, nullptr, 1024, D_MODEL, C.w_abc_t(l), 4096, scr, r, lane); return; } r -= I_B;
    if (r < I_OUT) { ti_finish(v, nullptr, D_MODEL, D_MODEL, C.w_out_t(l), 0, scr, r, lane); return; } r -= I_OUT;
    if (r < I_UP) { ti_finish(v, C.in[17] + (size_t)l * D_MODEL, D_MODEL, D_FF, C.w_up_t(l), 0, scr, r, lane); return; } r -= I_UP;
    ti_finish(v, nullptr, D_FF, D_MODEL, C.w_dn_t(l), 0, scr, r, lane);
}
struct ItemP { const float* W; bf16* WT; int K, N, row_off, gsel, item; };
__device__ __forceinline__ ItemP item_params(const Ctx& C, int l, int r) {
    ItemP P;
    if (r < I_IN) { P.W = C.in[2] + (size_t)l * D_MODEL * N_IN; P.WT = C.w_in_t(l); P.K = D_MODEL; P.N = N_IN; P.row_off = 0; P.gsel = 0; P.item = r; return P; } r -= I_IN;
    if (r < I_B) { P.W = C.in[5] + (size_t)l * 1024 * D_MODEL; P.WT = C.w_abc_t(l); P.K = 1024; P.N = D_MODEL; P.row_off = 0; P.gsel = -1; P.item = r; return P; } r -= I_B;
    if (r < I_B) { P.W = C.in[13] + (size_t)l * 1024 * D_MODEL; P.WT = C.w_abc_t(l); P.K = 1024; P.N = D_MODEL; P.row_off = 2048; P.gsel = -1; P.item = r; return P; } r -= I_B;
    if (r < I_B) { P.W = C.in[15] + (size_t)l * 1024 * D_MODEL; P.WT = C.w_abc_t(l); P.K = 1024; P.N = D_MODEL; P.row_off = 4096; P.gsel = -1; P.item = r; return P; } r -= I_B;
    if (r < I_OUT) { P.W = C.in[16] + (size_t)l * D_MODEL * D_MODEL; P.WT = C.w_out_t(l); P.K = D_MODEL; P.N = D_MODEL; P.row_off = 0; P.gsel = -1; P.item = r; return P; } r -= I_OUT;
    if (r < I_UP) { P.W = C.in[18] + (size_t)l * D_MODEL * D_FF; P.WT = C.w_up_t(l); P.K = D_MODEL; P.N = D_FF; P.row_off = 0; P.gsel = D_MODEL; P.item = r; return P; } r -= I_UP;
    P.W = C.in[19] + (size_t)l * D_FF * D_MODEL; P.WT = C.w_dn_t(l); P.K = D_FF; P.N = D_MODEL; P.row_off = 0; P.gsel = -1; P.item = r; return P;
}
__device__ __forceinline__ void ti_load_asm(f4_t (&v)[16], const ItemP& P, int lane) {
    const int kblk = P.K / 64, nb = P.item / kblk, kb = P.item % kblk, k0 = 64 * kb, n0 = 64 * nb, r = lane >> 4, q = lane & 15;
    const float* p0 = P.W + (size_t)(k0 + r) * P.N + n0 + 4 * q; const size_t step = (size_t)4 * P.N;
#pragma unroll
    for (int i = 0; i < 16; ++i) { const float* p = p0 + i * step; asm volatile("global_load_dwordx4 %0, %1, off" : "=v"(v[i]) : "v"(p) : "memory"); }
}
__device__ __forceinline__ void ti_finish_lds(f4_t (&v)[16], const ItemP& P, const LAS float* gtab, LAS float* scr, int lane) {
    const int kblk = P.K / 64, nb = P.item / kblk, kb = P.item % kblk, k0 = 64 * kb, n0 = 64 * nb, r = lane >> 4, q = lane & 15;
    if (P.gsel >= 0) { const LAS float* gp = gtab + P.gsel + k0 + r;
#pragma unroll
        for (int i = 0; i < 16; ++i) v[i] *= gp[4 * i]; }
#pragma unroll
    for (int i = 0; i < 16; ++i) { LAS float* d = scr + (4 * i + r) * TR_PITCH + 4 * q; d[0] = v[i][0]; d[1] = v[i][1]; d[2] = v[i][2]; d[3] = v[i][3]; }
    LDS_WAIT(); asm volatile("" ::: "memory");
    const int c = lane & 7;
#pragma unroll
    for (int j = 0; j < 8; ++j) { const int n = (lane >> 3) + 8 * j; const LAS float* s = scr + (8 * c) * TR_PITCH + n;
        v4u o; o.x = cvt2(s[0 * TR_PITCH], s[1 * TR_PITCH]); o.y = cvt2(s[2 * TR_PITCH], s[3 * TR_PITCH]); o.z = cvt2(s[4 * TR_PITCH], s[5 * TR_PITCH]); o.w = cvt2(s[6 * TR_PITCH], s[7 * TR_PITCH]);
        *(v4u*)(P.WT + (size_t)(P.row_off + n0 + n) * P.K + k0 + 8 * c) = o; }
    LDS_WAIT(); asm volatile("" ::: "memory");
}
__device__ __forceinline__ void wait_vm_le(int n) {
    if (n >= 56) asm volatile("s_waitcnt vmcnt(56)" ::: "memory"); else if (n >= 48) asm volatile("s_waitcnt vmcnt(48)" ::: "memory"); else if (n >= 40) asm volatile("s_waitcnt vmcnt(40)" ::: "memory");
    else if (n >= 32) asm volatile("s_waitcnt vmcnt(32)" ::: "memory"); else if (n >= 24) asm volatile("s_waitcnt vmcnt(24)" ::: "memory"); else if (n >= 16) asm volatile("s_waitcnt vmcnt(16)" ::: "memory");
    else if (n >= 8) asm volatile("s_waitcnt vmcnt(8)" ::: "memory"); else asm volatile("s_waitcnt vmcnt(0)" ::: "memory");
}
#define TI_TIE(v) asm volatile("" : "+v"(v[0]), "+v"(v[1]), "+v"(v[2]), "+v"(v[3]), "+v"(v[4]), "+v"(v[5]), "+v"(v[6]), "+v"(v[7]), "+v"(v[8]), "+v"(v[9]), "+v"(v[10]), "+v"(v[11]), "+v"(v[12]), "+v"(v[13]), "+v"(v[14]), "+v"(v[15]) :: "memory")
__device__ __forceinline__ void ph_prologue(Ctx& C) {
    relaunder(C);
    LAS float* scr = (LAS float*)(C.lds + C.wave * TR_WAVE_BYTES);
    const int gw = C.bid * NWAVES + C.wave, NGW = C.G * NWAVES;
    for (int it = gw; it < NIT; it += NGW) { f4_t v[16]; conv_load(C, 0, it, v, C.lane); conv_finish(C, 0, it, v, scr, C.lane); }
    typedef float f4 __attribute__((ext_vector_type(4)));
    for (int m = gw; m < M_TOK; m += NGW) {
        const f4* xr = (const f4*)(C.in[0] + (size_t)m * D_MODEL) + C.lane;
        unsigned long long* b8 = (unsigned long long*)(C.xb() + (size_t)m * D_MODEL) + C.lane;
        float part[8];
#pragma unroll
        for (int j = 0; j < 8; ++j) { const f4 v = xr[64 * j]; b8[64 * j] = (unsigned long long)cvt2(v[0], v[1]) | ((unsigned long long)cvt2(v[2], v[3]) << 32);
            part[j] = wave_sum((v[0] * v[0] + v[1] * v[1]) + (v[2] * v[2] + v[3] * v[3]), C.lane); }
        if (C.lane == 0) { float* sp = C.ssa() + (size_t)m * 8;
#pragma unroll
            for (int j = 0; j < 8; ++j) sp[j] = part[j]; }
    }
}
constexpr int RS_OFF = RING_BYTES;
__device__ __forceinline__ const LAS float* stage_rstd(Ctx& C, const float* ss, int M, int N) {
    pg8::StaticOrder S; S.init(M, N, C.G, C.bid); pg8::Unit u0; S.next(0, u0);
    LAS float* t = (LAS float*)(C.lds + RS_OFF);
    if (C.tid < 256) t[C.tid] = row_rstd(ss, u0.pm * 256 + C.tid);
    asm volatile("s_waitcnt vmcnt(0) lgkmcnt(0)" ::: "memory"); __builtin_amdgcn_s_barrier(); asm volatile("" ::: "memory");
    return t;
}
__device__ __forceinline__ void ph_inproj(Ctx& C, int l) {
    relaunder(C);
    pg8::Gemm g{C.xb(), C.w_in_t(l), M_TOK, N_IN, D_MODEL}; pg8::StaticOrder S; S.init(M_TOK, N_IN, C.G, C.bid);
    pg8::EpiProj E{C.seg(0), C.gates(), stage_rstd(C, C.ssa(), M_TOK, N_IN), C.in[3] + (size_t)l * NGATE, C.kmsum(l)};
    pg8::gemm_phase<pg8::EpiProj, pg8::StaticOrder, true, true>(C.lds + RING_OFF, g, S, E, C.tid);
}
__device__ __forceinline__ void ph_merge(Ctx& C, int l) {
    relaunder(C);
    pg8::Gemm g{C.abc(0), C.w_abc_t(l), 3 * M_TOK, 3 * D_MODEL, 1024}; pg8::MergeOrder S; S.init(C.G, C.bid);
    pg8::EpiMerge E{(const unsigned char*)C.gates(), C.mb()};
    pg8::gemm_phase<pg8::EpiMerge, pg8::MergeOrder, true, true>(C.lds + RING_OFF, g, S, E, C.tid);
}
__device__ __forceinline__ void ph_out(Ctx& C, int l) {
    relaunder(C);
    pg8::Gemm g{C.mb(), C.w_out_t(l), M_TOK, D_MODEL, D_MODEL}; pg8::StaticOrder S; S.init(M_TOK, D_MODEL, C.G, C.bid);
    pg8::EpiResid E{C.xb(), C.ssb()};
    pg8::gemm_phase<pg8::EpiResid, pg8::StaticOrder, false, true>(C.lds + RING_OFF, g, S, E, C.tid);
}
__device__ __forceinline__ void ph_up(Ctx& C, int l) {
    relaunder(C);
    pg8::Gemm g{C.xb(), C.w_up_t(l), M_TOK, D_FF, D_MODEL}; pg8::StaticOrder S; S.init(M_TOK, D_FF, C.G, C.bid);
    pg8::EpiUp E{C.hid(), stage_rstd(C, C.ssb(), M_TOK, D_FF)};
    pg8::gemm_phase<pg8::EpiUp, pg8::StaticOrder, true, true>(C.lds + RING_OFF, g, S, E, C.tid);
}
constexpr size_t CTL_FINC = 3 * MiB + 512 * 1024;
__device__ __forceinline__ void ph_down(Ctx& C, int l) {
    relaunder(C);
    pg8::Gemm g{C.hid(), C.w_dn_t(l), M_TOK, D_MODEL, D_FF}; pg8::StaticOrder S; S.init(M_TOK, D_MODEL, C.G, C.bid);
    if (l + 1 < DEPTH) { pg8::EpiResid E{C.xb(), C.ssa()};
        pg8::gemm_phase<pg8::EpiResid, pg8::StaticOrder, false, true>(C.lds + RING_OFF, g, S, E, C.tid); }
    else { pg8::EpiResidFin E{C.xb(), C.ssb(), (unsigned*)(C.ws + WS_CTL + CTL_FINC), C.in[20], C.out};
        pg8::gemm_phase<pg8::EpiResidFin, pg8::StaticOrder, false, true>(C.lds + RING_OFF, g, S, E, C.tid); }
}
typedef short bf16x8_t __attribute__((ext_vector_type(8)));
typedef short s16x4_t __attribute__((ext_vector_type(4)));
typedef float f32x16_t __attribute__((ext_vector_type(16)));
typedef float f32x4_t __attribute__((ext_vector_type(4)));
__device__ __forceinline__ unsigned cvtpk(float lo, float hi) { typedef float f2 __attribute__((ext_vector_type(2))); typedef __bf16 b2 __attribute__((ext_vector_type(2))); f2 v = {lo, hi}; b2 b = __builtin_convertvector(v, b2); return __builtin_bit_cast(unsigned, b); }
__device__ __forceinline__ s16x4_t lds_tr(LAS const unsigned char* p) { return __builtin_bit_cast(s16x4_t, __builtin_amdgcn_ds_read_tr16_b64_v4i16((LAS s16x4_t*)p)); }
__device__ __forceinline__ int t5_bucket(int n) {
    if (n < 16) return n;
    const int large = 16 + (int)(logf((float)n / 16.f) / 2.0794415416798357f * 16.f);
    return large < 31 ? large : 31;
}
__device__ __forceinline__ float xhalf_max(float x) { float a = x, b = x; asm volatile("v_nop\n\tv_nop\n\tv_permlane32_swap_b32 %0, %1" : "+v"(a), "+v"(b)); return fmaxf(a, b); }
__device__ __forceinline__ float xhalf_sum(float x) { float a = x, b = x; asm volatile("v_nop\n\tv_nop\n\tv_permlane32_swap_b32 %0, %1" : "+v"(a), "+v"(b)); return a + b; }
__device__ __forceinline__ unsigned off_b(unsigned row, unsigned ch) { return 256u * row + 16u * (ch ^ (((row & 3) << 2) | ((row >> 2) & 3))); }


template <int OFF> __device__ __forceinline__ void vtr_issue(s16x4_t (&r)[8], const unsigned (&a)[8]) {
    asm volatile("ds_read_b64_tr_b16 %0, %8 offset:%16\n\tds_read_b64_tr_b16 %1, %9 offset:%17\n\tds_read_b64_tr_b16 %2, %10 offset:%16\n\tds_read_b64_tr_b16 %3, %11 offset:%17\n\t"
                 "ds_read_b64_tr_b16 %4, %12 offset:%16\n\tds_read_b64_tr_b16 %5, %13 offset:%17\n\tds_read_b64_tr_b16 %6, %14 offset:%16\n\tds_read_b64_tr_b16 %7, %15 offset:%17"
                 : "=&v"(r[0]), "=&v"(r[1]), "=&v"(r[2]), "=&v"(r[3]), "=&v"(r[4]), "=&v"(r[5]), "=&v"(r[6]), "=&v"(r[7])
                 : "v"(a[0]), "v"(a[1]), "v"(a[2]), "v"(a[3]), "v"(a[4]), "v"(a[5]), "v"(a[6]), "v"(a[7]), "n"(OFF), "n"(OFF + 2048) : "memory");
}
__device__ __forceinline__ void vtr_wait(s16x4_t (&r)[8], s16x4_t (&q)[8]) {
    asm volatile("s_waitcnt lgkmcnt(0)" : "+v"(r[0]), "+v"(r[1]), "+v"(r[2]), "+v"(r[3]), "+v"(r[4]), "+v"(r[5]), "+v"(r[6]), "+v"(r[7]),
                 "+v"(q[0]), "+v"(q[1]), "+v"(q[2]), "+v"(q[3]), "+v"(q[4]), "+v"(q[5]), "+v"(q[6]), "+v"(q[7]) :: "memory");
}
template <int N> __device__ __forceinline__ void vtr_wait2_n(s16x4_t (&r)[8], s16x4_t (&q)[8]) {
    asm volatile("s_waitcnt lgkmcnt(%16)" : "+v"(r[0]), "+v"(r[1]), "+v"(r[2]), "+v"(r[3]), "+v"(r[4]), "+v"(r[5]), "+v"(r[6]), "+v"(r[7]),
                 "+v"(q[0]), "+v"(q[1]), "+v"(q[2]), "+v"(q[3]), "+v"(q[4]), "+v"(q[5]), "+v"(q[6]), "+v"(q[7]) : "n"(N) : "memory");
}
template <int N> __device__ __forceinline__ void vtr_wait1_n(s16x4_t (&r)[8]) {
    asm volatile("s_waitcnt lgkmcnt(%8)" : "+v"(r[0]), "+v"(r[1]), "+v"(r[2]), "+v"(r[3]), "+v"(r[4]), "+v"(r[5]), "+v"(r[6]), "+v"(r[7]) : "n"(N) : "memory");
}
__device__ __forceinline__ bf16x8_t vcat(const s16x4_t a, const s16x4_t b) { return (bf16x8_t){a[0], a[1], a[2], a[3], b[0], b[1], b[2], b[3]}; }
constexpr int AT_K0 = 0, AT_V0 = 16384, AT_BUF = 32768, AT_TB = 65536, AT_CONV = 66048, AT_GAIN = AT_CONV + 4 * TR_WAVE_BYTES;
static_assert(AT_GAIN + 2 * D_MODEL * 4 <= MISC_OFF, "conversion scratch and gain table below the control words");
constexpr float AT_NEG = -1e30f;
__device__ __forceinline__ void attn_stage(Ctx& C, const bf16* Kg, const bf16* Vg, int b, int h, int key0, int buf, bool tail = false) {
#pragma unroll
    for (int pi = 0; pi < 4; ++pi) {
        if (pi >= 2 && !tail) break;
        const int p = tail ? (C.wave & 3) * 4 + pi : C.wave * 2 + pi, row = 4 * p + (C.lane >> 4), cs = C.lane & 15, ch = cs ^ (((row & 3) << 2) | ((row >> 2) & 3));
        const size_t goff = ((size_t)(b * SEQ + key0 + row) * 1024 + h * HD) * 2 + ch * 16;
        __builtin_amdgcn_global_load_lds((const unsigned*)((const char*)Kg + goff), (LAS unsigned*)(C.lds + buf * AT_BUF + AT_K0 + p * 1024), 16, 0, 0);
        __builtin_amdgcn_global_load_lds((const unsigned*)((const char*)Vg + goff), (LAS unsigned*)(C.lds + buf * AT_BUF + AT_V0 + p * 1024), 16, 0, 0);
    }
}
__device__ __forceinline__ void ph_attention(Ctx& C, int l) {
    relaunder(C);
    const bf16* Qg = C.seg(SEG_Q); const bf16* Kg = C.seg(SEG_K); const bf16* Vg = C.seg(SEG_V); bf16* Og = C.abc(0);
    const float* kms = C.kmsum(l); const float* rel = C.in[4];
    const int bid = C.bid, bh = (bid & 7) * 2 + ((bid >> 3) & 1), widx = bid >> 4, b = bh >> 3, h = bh & 7, ii = widx >> 1, half = widx & 1;
    const int lane = C.lane, wave = C.wave, grp = wave >> 2, wq = wave & 3, hi = lane >> 5, l31 = lane & 31;
    const int nown = grp ? 15 - ii : ii;
    const int r0 = half * 128 + wq * 32;
    const int rq = r0 + l31;
    const int nB = 15 - ii, ntiles = nB * 4 + (half ? 4 : 2);
    const int TA = ii * 4 + (half ? 4 : 2);
    const int nt_w = grp ? ntiles : TA;
    constexpr float LOG2E = 1.4426950408889634f, SC = 0.08838834764831845f * 1.4426950408889634f;
    LAS float* tb = (LAS float*)(C.lds + AT_TB);
    if (C.tid < 128) tb[C.tid] = rel[t5_bucket(C.tid) * NH + h] * LOG2E;
    const float c31 = rel[31 * NH + h] * LOG2E;
    attn_stage(C, Kg, Vg, b, h, 0, 0);
    bf16x8_t qf[8];
    { const bf16* qp = Qg + (size_t)(b * SEQ + nown * 256 + rq) * 1024 + h * HD + 8 * hi;
#pragma unroll
      for (int s = 0; s < 8; ++s) qf[s] = *(const bf16x8_t*)(qp + 16 * s); }
    unsigned selmask;
    {
        f32x16_t ga = {0.f, 0.f, 0.f, 0.f, 0.f, 0.f, 0.f, 0.f, 0.f, 0.f, 0.f, 0.f, 0.f, 0.f, 0.f, 0.f};
        const float* kp = kms + ((size_t)(bh * 16 + (l31 & 15))) * 128 + 8 * hi;
#pragma unroll
        for (int s = 0; s < 8; ++s) {
            f32x4_t v0 = *(const f32x4_t*)(kp + 16 * s), v1 = *(const f32x4_t*)(kp + 16 * s + 4);
            if (l31 >= 16) { v0 = (f32x4_t){0.f, 0.f, 0.f, 0.f}; v1 = v0; }
            v0 *= (1.f / 256.f); v1 *= (1.f / 256.f);
            unsigned hw[4], lw[4];
            hw[0] = cvtpk(v0[0], v0[1]); hw[1] = cvtpk(v0[2], v0[3]); hw[2] = cvtpk(v1[0], v1[1]); hw[3] = cvtpk(v1[2], v1[3]);
            lw[0] = cvtpk(v0[0] - bflo(hw[0]), v0[1] - bfhi(hw[0])); lw[1] = cvtpk(v0[2] - bflo(hw[1]), v0[3] - bfhi(hw[1]));
            lw[2] = cvtpk(v1[0] - bflo(hw[2]), v1[1] - bfhi(hw[2])); lw[3] = cvtpk(v1[2] - bflo(hw[3]), v1[3] - bfhi(hw[3]));
            const v4u hv = {hw[0], hw[1], hw[2], hw[3]}, lv = {lw[0], lw[1], lw[2], lw[3]};
            ga = __builtin_amdgcn_mfma_f32_32x32x16_bf16(__builtin_bit_cast(bf16x8_t, hv), qf[s], ga, 0, 0, 0);
            ga = __builtin_amdgcn_mfma_f32_32x32x16_bf16(__builtin_bit_cast(bf16x8_t, lv), qf[s], ga, 0, 0, 0);
        }
        float G[16];
#pragma unroll
        for (int r = 0; r < 8; ++r) { const float own = ga[r], oth = bperm(own, lane ^ 32); const int nlo = (r & 3) + 8 * (r >> 2); G[nlo] = hi ? oth : own; G[nlo + 4] = hi ? own : oth; }
#pragma unroll
        for (int n = 0; n < 16; ++n) G[n] = (n < nown) ? G[n] : -INFINITY;
        selmask = 0u;
#pragma unroll
        for (int k = 0; k < TOPK; ++k) {
            float best = G[0]; int bi = 0;
#pragma unroll
            for (int n = 1; n < 16; ++n) { const bool bt = G[n] > best; best = bt ? G[n] : best; bi = bt ? n : bi; }
            selmask |= (best > -INFINITY) ? (1u << bi) : 0u;
#pragma unroll
            for (int n = 0; n < 16; ++n) G[n] = (n == bi) ? -INFINITY : G[n];
        }
    }
    f32x16_t o[4];
#pragma unroll
    for (int c = 0; c < 4; ++c) o[c] = (f32x16_t){0.f, 0.f, 0.f, 0.f, 0.f, 0.f, 0.f, 0.f, 0.f, 0.f, 0.f, 0.f, 0.f, 0.f, 0.f, 0.f};
    float mrow = AT_NEG, lrow = 0.f;
    const unsigned kbase = off_b(l31, hi);
    unsigned vbase; { const unsigned blk = (lane >> 4) & 1, q4 = (lane & 15) >> 2, p4 = lane & 3; vbase = off_b(4 * hi + q4, 2 * blk + (p4 >> 1)) + 8 * (p4 & 1); }
    unsigned vad[8];
    { const unsigned lb = (unsigned)(size_t)C.lds;
#pragma unroll
      for (int c = 0; c < 4; ++c) { vad[2 * c] = lb + (vbase ^ (unsigned)(c << 6)); vad[2 * c + 1] = lb + ((vbase ^ (unsigned)(c << 6)) ^ 32u); } }
typedef __bf16 bf16x2_at __attribute__((ext_vector_type(2)));
#ifndef ATTN_IDLE
#define ATTN_IDLE(IT) do { __builtin_amdgcn_s_barrier(); } while (0)
#endif
#define ATTN_TILE(IT, BUFC, FARC) do { const int it = (IT); constexpr int BUF = (BUFC); constexpr bool FARONLY = (FARC); \
        asm volatile("s_waitcnt vmcnt(0) lgkmcnt(0)" ::: "memory"); \
        __builtin_amdgcn_s_barrier(); \
        asm volatile("" ::: "memory"); \
        if (it + 1 < ntiles && it < TA) attn_stage(C, Kg, Vg, b, h, (it + 1) * 64, BUF ^ 1, false);     \
        const int j = it >> 2, k0 = (it & 3) * 64; \
        if (j > nown) break; \
        const bool own = (j == nown); \
        if (own && k0 > r0 + 31) break; \
        bool rowsel = true; \
        if (!own) { rowsel = (selmask >> j) & 1u; const unsigned long long bal = __ballot(rowsel); if (bal == 0ull) break; } \
        LAS const unsigned char* kb = C.lds + BUF * AT_BUF + AT_K0; \
        constexpr int VOFF = BUF * AT_BUF + AT_V0; \
        f32x16_t sa0 = {0.f, 0.f, 0.f, 0.f, 0.f, 0.f, 0.f, 0.f, 0.f, 0.f, 0.f, 0.f, 0.f, 0.f, 0.f, 0.f}, sa1 = sa0; \
        bf16x8_t kg[4][4]; \
        _Pragma("unroll") for (int g = 0; g < 2; ++g) _Pragma("unroll") for (int e = 0; e < 2; ++e) { const unsigned ka = kbase ^ (unsigned)((2 * g + e) << 5); kg[g][2 * e] = *(LAS const bf16x8_t*)(kb + ka); kg[g][2 * e + 1] = *(LAS const bf16x8_t*)(kb + 8192 + ka); } \
        __builtin_amdgcn_sched_barrier(0); \
        s16x4_t vr0[8], vr1[8]; \
        _Pragma("unroll") for (int g = 0; g < 4; ++g) { \
            if (g + 2 < 4) { _Pragma("unroll") for (int e = 0; e < 2; ++e) { const unsigned ka = kbase ^ (unsigned)((2 * (g + 2) + e) << 5); kg[g + 2][2 * e] = *(LAS const bf16x8_t*)(kb + ka); kg[g + 2][2 * e + 1] = *(LAS const bf16x8_t*)(kb + 8192 + ka); } } \
            __builtin_amdgcn_sched_barrier(0); \
            _Pragma("unroll") for (int e = 0; e < 2; ++e) { sa0 = __builtin_amdgcn_mfma_f32_32x32x16_bf16(kg[g][2 * e], qf[2 * g + e], sa0, 0, 0, 0); sa1 = __builtin_amdgcn_mfma_f32_32x32x16_bf16(kg[g][2 * e + 1], qf[2 * g + e], sa1, 0, 0, 0); } \
            __builtin_amdgcn_sched_barrier(0); \
        } \
        vtr_issue<VOFF>(vr0, vad); vtr_issue<VOFF + 4096>(vr1, vad);      \
        __builtin_amdgcn_sched_barrier(0); \
        float pv[32]; \
        if constexpr (FARONLY) {                                          \
            float mr = fmaxf(sa0[0], sa1[0]); \
            _Pragma("unroll") for (int r = 1; r < 16; ++r) mr = fmaxf(fmaxf(mr, sa0[r]), sa1[r]); \
            float mx = xhalf_max(mr) * SC + c31; \
            if (!rowsel) mx = AT_NEG; \
            if (!__all(mx - mrow <= 8.0f)) { \
                const float mnew = fmaxf(mrow, mx), alpha = __builtin_amdgcn_exp2f(mrow - mnew); \
                mrow = mnew; lrow *= alpha; \
                _Pragma("unroll") for (int c = 0; c < 4; ++c) o[c] *= alpha; \
            } \
            const float off = rowsel ? c31 - mrow : AT_NEG;               \
            _Pragma("unroll") for (int r = 0; r < 16; ++r) { pv[r] = __builtin_amdgcn_exp2f(sa0[r] * SC + off); pv[16 + r] = __builtin_amdgcn_exp2f(sa1[r] * SC + off); } \
        } else { \
        const int mind = (nown - j) * 256 + r0 - (k0 + 63); \
        if (mind >= 113) { \
            _Pragma("unroll") for (int r = 0; r < 16; ++r) { pv[r] = sa0[r] * SC + c31; pv[16 + r] = sa1[r] * SC + c31; } \
        } else { \
            const int dbase = (nown - j) * 256 + rq - k0 - 4 * hi; \
            _Pragma("unroll") for (int r = 0; r < 32; ++r) { const int kr = (r & 3) + 8 * ((r & 15) >> 2) + 32 * (r >> 4); int d = dbase - kr; const bool masked = d < 0; d = d < 0 ? 0 : (d > 127 ? 127 : d); \
                const float sc = (r < 16 ? sa0[r & 15] : sa1[r & 15]) * SC + tb[d]; pv[r] = masked ? AT_NEG : sc; } \
        } \
        float mx = pv[0]; \
        _Pragma("unroll") for (int r = 1; r < 32; ++r) mx = fmaxf(mx, pv[r]); \
        mx = xhalf_max(mx); \
        if (!rowsel) mx = AT_NEG; \
        if (!__all(mx - mrow <= 8.0f)) { \
            const float mnew = fmaxf(mrow, mx), alpha = __builtin_amdgcn_exp2f(mrow - mnew); \
            mrow = mnew; lrow *= alpha; \
            _Pragma("unroll") for (int c = 0; c < 4; ++c) o[c] *= alpha; \
        } \
        { const float msub = rowsel ? mrow : -AT_NEG;                      \
          _Pragma("unroll") for (int r = 0; r < 32; ++r) pv[r] = __builtin_amdgcn_exp2f(pv[r] - msub); } \
        } \
        unsigned pwd[16]; float ps0 = 0.f, ps1 = 0.f;                      \
        _Pragma("unroll") for (int i = 0; i < 16; i += 2) { pwd[i] = cvtpk(pv[2 * i], pv[2 * i + 1]); pwd[i + 1] = cvtpk(pv[2 * i + 2], pv[2 * i + 3]); \
            ps0 = __builtin_amdgcn_fdot2_f32_bf16(__builtin_bit_cast(bf16x2_at, pwd[i]), __builtin_bit_cast(bf16x2_at, 0x3f803f80u), ps0, false); \
            ps1 = __builtin_amdgcn_fdot2_f32_bf16(__builtin_bit_cast(bf16x2_at, pwd[i + 1]), __builtin_bit_cast(bf16x2_at, 0x3f803f80u), ps1, false); } \
        lrow += xhalf_sum(ps0 + ps1); \
        bf16x8_t pf[4]; \
        _Pragma("unroll") for (int ks = 0; ks < 4; ++ks) { const v4u pw = {pwd[4 * ks], pwd[4 * ks + 1], pwd[4 * ks + 2], pwd[4 * ks + 3]}; pf[ks] = __builtin_bit_cast(bf16x8_t, pw); } \
        __builtin_amdgcn_sched_barrier(0); \
        s16x4_t vr2[8], vr3[8];                                           \
        vtr_issue<VOFF + 8192>(vr2, vad); \
        vtr_wait2_n<8>(vr0, vr1);                                         \
        _Pragma("unroll") for (int c = 0; c < 4; ++c) o[c] = __builtin_amdgcn_mfma_f32_32x32x16_bf16(vcat(vr0[2 * c], vr0[2 * c + 1]), pf[0], o[c], 0, 0, 0); \
        vtr_issue<VOFF + 12288>(vr3, vad); \
        __builtin_amdgcn_sched_barrier(0); \
        _Pragma("unroll") for (int c = 0; c < 4; ++c) o[c] = __builtin_amdgcn_mfma_f32_32x32x16_bf16(vcat(vr1[2 * c], vr1[2 * c + 1]), pf[1], o[c], 0, 0, 0); \
        __builtin_amdgcn_sched_barrier(0); \
        vtr_wait1_n<8>(vr2);                                              \
        _Pragma("unroll") for (int c = 0; c < 4; ++c) o[c] = __builtin_amdgcn_mfma_f32_32x32x16_bf16(vcat(vr2[2 * c], vr2[2 * c + 1]), pf[2], o[c], 0, 0, 0); \
        __builtin_amdgcn_sched_barrier(0); \
        vtr_wait1_n<0>(vr3); \
        _Pragma("unroll") for (int c = 0; c < 4; ++c) o[c] = __builtin_amdgcn_mfma_f32_32x32x16_bf16(vcat(vr3[2 * c], vr3[2 * c + 1]), pf[3], o[c], 0, 0, 0); \
        __builtin_amdgcn_sched_barrier(0); \
    } while (0)
    int tfar; { const int q_ = nown * 256 + r0 - 176; tfar = q_ < 0 ? 0 : ((q_ >> 6) + 1); tfar &= ~1; if (tfar > nt_w) tfar = nt_w; }
    for (int it2 = 0; it2 < tfar; it2 += 2) { ATTN_TILE(it2, 0, true); ATTN_TILE(it2 + 1, 1, true); }
    for (int it2 = tfar; it2 < nt_w; it2 += 2) { ATTN_TILE(it2, 0, false); ATTN_TILE(it2 + 1, 1, false); }
#undef ATTN_TILE
    const float inv = 1.f / lrow;
    bf16* op = Og + (size_t)(b * SEQ + nown * 256 + rq) * 1024 + h * HD + 8 * hi;
#pragma unroll
    for (int c = 0; c < 4; ++c)
#pragma unroll
        for (int k = 0; k < 2; ++k) {
            unsigned ax = cvtpk(o[c][8 * k + 0] * inv, o[c][8 * k + 1] * inv), ay = cvtpk(o[c][8 * k + 2] * inv, o[c][8 * k + 3] * inv);
            unsigned bx = cvtpk(o[c][8 * k + 4] * inv, o[c][8 * k + 5] * inv), by = cvtpk(o[c][8 * k + 6] * inv, o[c][8 * k + 7] * inv);
            asm volatile("v_nop\n\tv_nop\n\tv_permlane32_swap_b32 %0, %1" : "+v"(ax), "+v"(bx));
            asm volatile("v_nop\n\tv_nop\n\tv_permlane32_swap_b32 %0, %1" : "+v"(ay), "+v"(by));
            const v4u w = {ax, ay, bx, by};
            *(v4u*)(op + 32 * c + 16 * k) = w; }
    asm volatile("s_waitcnt vmcnt(0)" ::: "memory");
    {
        const bool conv = l + 1 < DEPTH;
        LAS float* scr = (LAS float*)(C.lds + AT_CONV + wq * TR_WAVE_BYTES);
        LAS float* gtab = (LAS float*)(C.lds + AT_GAIN);
        if (conv && nt_w < ntiles) {
            const int t = wq * 64 + lane;
#pragma unroll
            for (int j = 0; j < 2; ++j) { const float* g = (j ? C.in[17] : C.in[1]) + (size_t)(l + 1) * D_MODEL;
#pragma unroll
                for (int u = 0; u < 2; ++u) *(LAS f4_t*)(gtab + j * D_MODEL + 8 * t + 4 * u) = *(const f4_t*)(g + 8 * t + 4 * u); }
            asm volatile("s_waitcnt vmcnt(0) lgkmcnt(0)" ::: "memory");
        }
        const int sbase = (bh * 2 + half) * 1024 + 240 * ii - 16 * ii * (ii - 1) + wq;
        f4_t va[16], vb[16];
#pragma unroll
        for (int i = 0; i < 16; ++i) { va[i] = (f4_t){0.f, 0.f, 0.f, 0.f}; vb[i] = va[i]; }
        int ra = -1, rb = -1, aft_a = 0, aft_b = 0;
#define AT_IDLE_STEP(IT, VX, RX, AFX, AFY) do { const int it_ = (IT); \
            __builtin_amdgcn_s_barrier(); asm volatile("" ::: "memory"); \
            if (it_ + 1 < ntiles) { attn_stage(C, Kg, Vg, b, h, (it_ + 1) * 64, (it_ + 1) & 1, true); AFX += 8; AFY += 8; } \
            int adma = 0; \
            if (conv) { int ll = l + 1, ln = lane; asm volatile("" : "+s"(ll), "+v"(ln));     \
                if (RX >= 0) { wait_vm_le(AFX); TI_TIE(VX); const ItemP P = item_params(C, ll, RX); ti_finish_lds(VX, P, gtab, scr, ln); AFY += 8; adma += 8; } \
                const int slot = sbase + (it_ - TA) * 4, s64 = (slot * 37) & 63; RX = s64 < 35 ? (slot >> 6) * 35 + s64 : -1; \
                if (RX >= 0) { const ItemP P = item_params(C, ll, RX); ti_load_asm(VX, P, ln); AFX = 0; AFY += 16; adma += 16; } } \
            wait_vm_le(adma); } while (0)
        for (int it = nt_w; it < ntiles; it += 2) { AT_IDLE_STEP(it, va, ra, aft_a, aft_b); AT_IDLE_STEP(it + 1, vb, rb, aft_b, aft_a); }
#undef AT_IDLE_STEP
        asm volatile("s_waitcnt vmcnt(0)" ::: "memory");
        if (ra >= 0) { TI_TIE(va); const ItemP P = item_params(C, l + 1, ra); ti_finish_lds(va, P, gtab, scr, lane); }
        if (rb >= 0) { TI_TIE(vb); const ItemP P = item_params(C, l + 1, rb); ti_finish_lds(vb, P, gtab, scr, lane); }
    }
    asm volatile("s_waitcnt vmcnt(0)" ::: "memory");
    __builtin_amdgcn_s_barrier();
}
constexpr int LR_PITCH = 272;
constexpr size_t CTL_LRUF = 2 * MiB;
__device__ __forceinline__ float gelu_t(float x) { return x * __builtin_amdgcn_rcpf(1.f + __builtin_amdgcn_exp2f(-2.3022081984f * x * (1.f + 0.044715f * x * x))); }
constexpr size_t WS_LHG = WS_END, WS_LPG = WS_END + (size_t)M_TOK * LRU_W * 4, WS_END2 = WS_LPG + (size_t)M_TOK * LRU_W * 4;
__device__ __forceinline__ void lru_local(Ctx& C, int l) {
    relaunder(C);
    const int bid = C.bid, b = bid >> 7, g = (bid >> 4) & 7, c = bid & 15, tid = C.tid, lane = C.lane, wave = C.wave;
    const bf16* XR = C.seg(SEG_XR); const bf16* GR = C.seg(SEG_GR);
    unsigned* HP = (unsigned*)(C.ws + WS_LHG);
    const float* cw = C.in[6] + (size_t)l * 4 * LRU_W; const float* cb = C.in[7] + (size_t)l * LRU_W;
    const float* wa = C.in[8] + (size_t)l * LRU_G * LRU_BW * LRU_BW; const float* ba = C.in[9] + (size_t)l * LRU_W;
    const float* wx = C.in[10] + (size_t)l * LRU_G * LRU_BW * LRU_BW; const float* bx = C.in[11] + (size_t)l * LRU_W; const float* lam = C.in[12] + (size_t)l * LRU_W;
    unsigned long long* sums = (unsigned long long*)(C.ws + WS_LRUS) + (size_t)l * 256 * 128;
    unsigned* flags = (unsigned*)(C.ws + WS_CTL + CTL_LRUF) + (size_t)l * 256 * 64;
    const int tok0 = b * SEQ + c * 256;
    {
        const int ck = tid & 15, ch0 = g * 128 + ck * 8;
        float w[4][8], bb[8];
#pragma unroll
        for (int k = 0; k < 4; ++k) { const f32x4_t a0 = *(const f32x4_t*)(cw + k * LRU_W + ch0), a1 = *(const f32x4_t*)(cw + k * LRU_W + ch0 + 4);
#pragma unroll
            for (int j = 0; j < 4; ++j) { w[k][j] = a0[j]; w[k][4 + j] = a1[j]; } }
        { const f32x4_t a0 = *(const f32x4_t*)(cb + ch0), a1 = *(const f32x4_t*)(cb + ch0 + 4);
#pragma unroll
          for (int j = 0; j < 4; ++j) { bb[j] = a0[j]; bb[4 + j] = a1[j]; } }
#pragma unroll 2
        for (int i = 0; i < 8; ++i) {
            const int t = (tid >> 4) + 32 * i;
            float acc[8];
#pragma unroll
            for (int j = 0; j < 8; ++j) acc[j] = bb[j];
#pragma unroll
            for (int k = 0; k < 4; ++k) { const int ts = c * 256 + t - 3 + k;
                if (ts >= 0) { const v4u v = *(const v4u*)(XR + (size_t)(b * SEQ + ts) * 1024 + ch0);
                    acc[0] += w[k][0] * bflo(v.x); acc[1] += w[k][1] * bfhi(v.x); acc[2] += w[k][2] * bflo(v.y); acc[3] += w[k][3] * bfhi(v.y);
                    acc[4] += w[k][4] * bflo(v.z); acc[5] += w[k][5] * bfhi(v.z); acc[6] += w[k][6] * bflo(v.w); acc[7] += w[k][7] * bfhi(v.w); } }
            const v4u o = {cvtpk(acc[0], acc[1]), cvtpk(acc[2], acc[3]), cvtpk(acc[4], acc[5]), cvtpk(acc[6], acc[7])};
            *(LAS v4u*)(C.lds + t * LR_PITCH + ck * 16) = o;
        }
    }
    asm volatile("s_waitcnt vmcnt(0) lgkmcnt(0)" ::: "memory"); __builtin_amdgcn_s_barrier(); asm volatile("" ::: "memory");
    const int chn = wave * 16 + (lane & 15);
    const int n16 = lane & 15, q4 = lane >> 4, chg = g * 128 + chn;
    bf16x8_t fa[4], fx[4];
#pragma unroll
    for (int ks = 0; ks < 4; ++ks) { float va[8], vx[8];
#pragma unroll
        for (int j = 0; j < 8; ++j) { const size_t o = ((size_t)g * 128 + 32 * ks + 8 * q4 + j) * 128 + wave * 16 + n16; va[j] = wa[o]; vx[j] = wx[o]; }
        const v4u pa = {cvtpk(va[0], va[1]), cvtpk(va[2], va[3]), cvtpk(va[4], va[5]), cvtpk(va[6], va[7])}, px = {cvtpk(vx[0], vx[1]), cvtpk(vx[2], vx[3]), cvtpk(vx[4], vx[5]), cvtpk(vx[6], vx[7])};
        fa[ks] = __builtin_bit_cast(bf16x8_t, pa); fx[ks] = __builtin_bit_cast(bf16x8_t, px); }
    const float bav = ba[chg], bxv = bx[chg];
    float spv; { const float nl = -lam[chg]; spv = fmaxf(nl, 0.f) + log1pf(expf(-fabsf(nl))); }
    const float m8sp = -8.0f * spv * 1.4426950408889634f;
    float carry = 0.f, Ptot = 1.f;
#pragma unroll 2
    for (int tt = 0; tt < 16; ++tt) {
        f32x4_t ar = {0.f, 0.f, 0.f, 0.f}, ai = {0.f, 0.f, 0.f, 0.f};
#pragma unroll
        for (int ks = 0; ks < 4; ++ks) { const bf16x8_t af = *(LAS const bf16x8_t*)(C.lds + (16 * tt + n16) * LR_PITCH + (32 * ks + 8 * q4) * 2);
            ar = __builtin_amdgcn_mfma_f32_16x16x32_bf16(af, fa[ks], ar, 0, 0, 0); ai = __builtin_amdgcn_mfma_f32_16x16x32_bf16(af, fx[ks], ai, 0, 0, 0); }
        float P[4], H[4], gl[4];
#pragma unroll
        for (int i = 0; i < 4; ++i) gl[i] = bf2f(GR[(size_t)(tok0 + 16 * tt + 4 * q4 + i) * 1024 + chg]);
#pragma unroll
        for (int i = 0; i < 4; ++i) {
            const int t = 16 * tt + 4 * q4 + i;
            const float xcv = bf2f(*(LAS const unsigned short*)(C.lds + t * LR_PITCH + chn * 2));
            const float r = pg8::sigm(ar[i] + bav), ig = pg8::sigm(ai[i] + bxv);
            const float l2a = m8sp * r;
            const float a = __builtin_amdgcn_exp2f(l2a);
            const float y = 1.3862943611198906f * l2a;
            const float ser = -y * (1.f + y * (0.5f + y * (0.16666667f + y * (0.041666668f + y * 0.008333334f))));
            const float big = 1.f - a * a;
            const float om = y > -0.25f ? ser : big;
            const float u = __builtin_amdgcn_sqrtf(om) * ig * xcv;
            if (i == 0) { P[0] = a; H[0] = u; } else { P[i] = a * P[i - 1]; H[i] = a * H[i - 1] + u; }
        }
        float Pq[4], Hq[4];
#pragma unroll
        for (int qq = 0; qq < 4; ++qq) { Pq[qq] = bperm(P[3], n16 + 16 * qq); Hq[qq] = bperm(H[3], n16 + 16 * qq); }
        const float c0 = carry, c1 = Hq[0] + Pq[0] * c0, c2 = Hq[1] + Pq[1] * c1, c3 = Hq[2] + Pq[2] * c2;
        const float p0 = Ptot, p1 = p0 * Pq[0], p2 = p1 * Pq[1], p3 = p2 * Pq[2];
        carry = Hq[3] + Pq[3] * c3; Ptot = p3 * Pq[3];
        const float cin = q4 == 0 ? c0 : (q4 == 1 ? c1 : (q4 == 2 ? c2 : c3)), pin = q4 == 0 ? p0 : (q4 == 1 ? p1 : (q4 == 2 ? p2 : p3));
#pragma unroll
        for (int i = 0; i < 4; ++i) { const size_t o = (size_t)(tok0 + 16 * tt + 4 * q4 + i) * 1024 + chg; const float ge = gelu_t(gl[i]);
            HP[o] = cvtpk((H[i] + P[i] * cin) * ge, (P[i] * pin) * ge); }
    }
    if (q4 == 0) __hip_atomic_store(sums + (size_t)bid * 128 + chn, ((unsigned long long)__builtin_bit_cast(unsigned, carry) << 32) | (unsigned long long)__builtin_bit_cast(unsigned, Ptot), __ATOMIC_RELAXED, __HIP_MEMORY_SCOPE_AGENT);
    asm volatile("s_waitcnt vmcnt(0) lgkmcnt(0)" ::: "memory");
    __builtin_amdgcn_s_barrier();
    if (tid == 0) __hip_atomic_store(flags + (size_t)bid * 64, 1u, __ATOMIC_RELAXED, __HIP_MEMORY_SCOPE_AGENT);
}
__device__ __forceinline__ void lru_fix(Ctx& C, int l) {
    relaunder(C);
    const int bid = C.bid, b = bid >> 7, g = (bid >> 4) & 7, c = bid & 15, tid = C.tid, lane = C.lane, wave = C.wave;
    const unsigned* HP = (const unsigned*)(C.ws + WS_LHG); bf16* OB = C.abc(1);
    const unsigned long long* sums = (const unsigned long long*)(C.ws + WS_LRUS) + (size_t)l * 256 * 128;
    const unsigned* flags = (const unsigned*)(C.ws + WS_CTL + CTL_LRUF) + (size_t)l * 256 * 64;
    LAS float* cl = (LAS float*)C.lds;
    if (wave == 0) {
        if (lane < c) { const unsigned* f = flags + (size_t)((bid & ~15) + lane) * 64; unsigned spins = 0;
            while (__hip_atomic_load(f, __ATOMIC_RELAXED, __HIP_MEMORY_SCOPE_AGENT) == 0u) { __builtin_amdgcn_s_sleep(2); if (++spins > (1u << 22)) break; } }
        __builtin_amdgcn_fence(__ATOMIC_ACQUIRE, "agent");
        asm volatile("s_waitcnt vmcnt(0)" ::: "memory");
    }
    asm volatile("s_waitcnt vmcnt(0) lgkmcnt(0)" ::: "memory"); __builtin_amdgcn_s_barrier(); asm volatile("" ::: "memory");
    if (tid < 128) { float carry = 0.f;
        for (int cc = 0; cc < c; ++cc) { const unsigned long long v = __hip_atomic_load(sums + (size_t)((bid & ~15) + cc) * 128 + tid, __ATOMIC_RELAXED, __HIP_MEMORY_SCOPE_AGENT);
            const float A = __builtin_bit_cast(float, (unsigned)v), H = __builtin_bit_cast(float, (unsigned)(v >> 32)); carry = H + A * carry; }
        cl[tid] = carry; }
    asm volatile("s_waitcnt vmcnt(0) lgkmcnt(0)" ::: "memory"); __builtin_amdgcn_s_barrier(); asm volatile("" ::: "memory");
    const int ck = tid & 15; float cr[8];
#pragma unroll
    for (int j = 0; j < 8; ++j) cr[j] = cl[ck * 8 + j];
    const size_t base = (size_t)(b * SEQ + c * 256) * 1024 + g * 128 + ck * 8;
#pragma unroll 4
    for (int i = 0; i < 8; ++i) { const size_t o = base + (size_t)((tid >> 4) + 32 * i) * 1024;
        const v4u w0 = *(const v4u*)(HP + o), w1 = *(const v4u*)(HP + o + 4);
        const v4u r = {cvtpk(bflo(w0.x) + bfhi(w0.x) * cr[0], bflo(w0.y) + bfhi(w0.y) * cr[1]), cvtpk(bflo(w0.z) + bfhi(w0.z) * cr[2], bflo(w0.w) + bfhi(w0.w) * cr[3]),
                       cvtpk(bflo(w1.x) + bfhi(w1.x) * cr[4], bflo(w1.y) + bfhi(w1.y) * cr[5]), cvtpk(bflo(w1.z) + bfhi(w1.z) * cr[6], bflo(w1.w) + bfhi(w1.w) * cr[7])};
        *(v4u*)(OB + o) = r; }
    asm volatile("s_waitcnt vmcnt(0) lgkmcnt(0)" ::: "memory"); __builtin_amdgcn_s_barrier();
}
__device__ __forceinline__ void ph_shortconv(Ctx& C, int l) {
    relaunder(C);
    const bf16* SB = C.seg(SEG_SCB); const bf16* SCc = C.seg(SEG_SCC); const bf16* SX = C.seg(SEG_SCX); bf16* OC = C.abc(2);
    const float* cw = C.in[14] + (size_t)l * 3 * SC_W;
    const int ck = C.tid & 127, ch0 = ck * 8;
    float w[3][8];
#pragma unroll
    for (int k = 0; k < 3; ++k) { const f32x4_t a0 = *(const f32x4_t*)(cw + k * SC_W + ch0), a1 = *(const f32x4_t*)(cw + k * SC_W + ch0 + 4);
#pragma unroll
        for (int j = 0; j < 4; ++j) { w[k][j] = a0[j]; w[k][4 + j] = a1[j]; } }
    for (int i = 0; i < 8; ++i) {
        const int row = C.bid * 32 + (C.tid >> 7) + 4 * i, t = row & (SEQ - 1);
        float acc[8];
#pragma unroll
        for (int j = 0; j < 8; ++j) acc[j] = 0.f;
#pragma unroll
        for (int k = 0; k < 3; ++k) { if (t - 2 + k >= 0) { const size_t o = (size_t)(row - 2 + k) * 1024 + ch0; const v4u cv = *(const v4u*)(SCc + o), xv = *(const v4u*)(SX + o);
                acc[0] += w[k][0] * (bflo(cv.x) * bflo(xv.x)); acc[1] += w[k][1] * (bfhi(cv.x) * bfhi(xv.x)); acc[2] += w[k][2] * (bflo(cv.y) * bflo(xv.y)); acc[3] += w[k][3] * (bfhi(cv.y) * bfhi(xv.y));
                acc[4] += w[k][4] * (bflo(cv.z) * bflo(xv.z)); acc[5] += w[k][5] * (bfhi(cv.z) * bfhi(xv.z)); acc[6] += w[k][6] * (bflo(cv.w) * bflo(xv.w)); acc[7] += w[k][7] * (bfhi(cv.w) * bfhi(xv.w)); } }
        const size_t o = (size_t)row * 1024 + ch0; const v4u bv = *(const v4u*)(SB + o);
        const v4u r = {cvtpk(acc[0] * bflo(bv.x), acc[1] * bfhi(bv.x)), cvtpk(acc[2] * bflo(bv.y), acc[3] * bfhi(bv.y)), cvtpk(acc[4] * bflo(bv.z), acc[5] * bfhi(bv.z)), cvtpk(acc[6] * bflo(bv.w), acc[7] * bfhi(bv.w))};
        *(v4u*)(OC + o) = r;
    }
}
__device__ __forceinline__ void ph_mixers(Ctx& C, int l) {
    lru_local(C, l);
    ph_shortconv(C, l);
    asm volatile("s_waitcnt vmcnt(0) lgkmcnt(0)" ::: "memory"); __builtin_amdgcn_s_barrier();
    ph_attention(C, l);
    lru_fix(C, l);
}


#define XB_TMO      128
#define XB_XCNT(j)  (256  + 64 * (j))
#define XB_XSUB(j)  (1280 + 64 * (j))
#define XB_XGEN(j)  (2304 + 64 * (j))
#define XB_TOP      3328
#define XB_TOPGEN   3392
#define XCD_BAR_WORDS 3456
#define XB_SPIN_CAP (1u << 18)

__device__ __forceinline__ unsigned xb_ld(unsigned* p)              { return __hip_atomic_load(p, __ATOMIC_RELAXED, __HIP_MEMORY_SCOPE_AGENT); }
__device__ __forceinline__ unsigned xb_add(unsigned* p, unsigned v) { return __hip_atomic_fetch_add(p, v, __ATOMIC_RELAXED, __HIP_MEMORY_SCOPE_AGENT); }
__device__ __forceinline__ unsigned xb_xcc_id() { return (unsigned)__builtin_amdgcn_s_getreg((3 << 11) | 20) & 0xFu; }
#define XB_SPIN(cond, bar) do { unsigned _sp = 0; while (cond) { __builtin_amdgcn_s_sleep(1); \
    if ((++_sp & 255u) == 0u) { if (xb_ld(&(bar)[XB_TMO])) break; if (_sp > XB_SPIN_CAP) { atomicAdd(&(bar)[XB_TMO], 1u); break; } } } } while (0)

struct XcdBarrier {
    unsigned* bar; unsigned x;
    volatile LAS unsigned* st;
};

__device__ __forceinline__ XcdBarrier xcd_barrier_post(unsigned* bar, volatile LAS unsigned* st) {
    XcdBarrier b; b.bar = bar; b.x = xb_xcc_id(); b.st = st;
    if (threadIdx.x == 0) (void)xb_add(&bar[XB_XCNT(b.x)], 1u);
    return b;
}
__device__ __forceinline__ void xcd_barrier_complete(unsigned* bar, unsigned x, unsigned& nloc, unsigned& nx) {
    const unsigned G = gridDim.x * gridDim.y * gridDim.z;
    unsigned sum, cnt, mine, sp = 0u;
    for (;;) {
        sum = 0u; cnt = 0u; mine = 0u;
#pragma unroll
        for (unsigned j = 0; j < 16; ++j) { const unsigned c = xb_ld(&bar[XB_XCNT(j)]); sum += c; cnt += (c > 0u) ? 1u : 0u; mine = (j == x) ? c : mine; }
        if (sum == G) break;
        __builtin_amdgcn_s_sleep(1);
        if ((++sp & 255u) == 0u) { if (xb_ld(&bar[XB_TMO])) break; if (sp > XB_SPIN_CAP) { atomicAdd(&bar[XB_TMO], 1u); break; } }
    }
    nloc = mine > 0u ? mine : 1u; nx = cnt > 0u ? cnt : 1u;
}

__device__ __forceinline__ void xcd_barrier(const XcdBarrier& b) {
    asm volatile("s_waitcnt vmcnt(0)" ::: "memory");
    __syncthreads();
    if (threadIdx.x == 0) {
        unsigned* bar = b.bar;
        __builtin_amdgcn_s_waitcnt(0);
        unsigned nloc = b.st[0], nx = b.st[1];
        if (nloc == 0u) { xcd_barrier_complete(bar, b.x, nloc, nx); b.st[0] = nloc; b.st[1] = nx; }
        const unsigned old = xb_add(&bar[XB_XSUB(b.x)], 1u);
        const unsigned gen = old / nloc;
        if (old + 1u == (gen + 1u) * nloc) {
            __builtin_amdgcn_fence(__ATOMIC_RELEASE, "agent");
            asm volatile("s_waitcnt vmcnt(0)" ::: "memory");
            const unsigned og = xb_add(&bar[XB_TOP], 1u);
            const unsigned tg = og / nx;
            if (og + 1u == (tg + 1u) * nx) xb_add(&bar[XB_TOPGEN], 1u);
            else XB_SPIN(xb_ld(&bar[XB_TOPGEN]) == tg, bar);
            __builtin_amdgcn_fence(__ATOMIC_ACQUIRE, "agent");
            xb_add(&bar[XB_XGEN(b.x)], 1u);
            asm volatile("s_waitcnt vmcnt(0)" ::: "memory");
        } else {
            XB_SPIN(xb_ld(&bar[XB_XGEN(b.x)]) == gen, bar);
            __builtin_amdgcn_fence(__ATOMIC_ACQUIRE, "agent");
            asm volatile("s_waitcnt vmcnt(0)" ::: "memory");
        }
    }
    __syncthreads();
}


constexpr size_t CTL_BAR = 65536;
__device__ __forceinline__ void make_ctx(Ctx& C, const Args& a, unsigned char* lds) {
    C.lds = (LAS unsigned char*)lds; C.tid = threadIdx.x; C.lane = C.tid & 63; C.wave = __builtin_amdgcn_readfirstlane(C.tid >> 6); C.G = gridDim.x; C.bid = blockIdx.x;
#pragma unroll
    for (int i = 0; i < 21; ++i) C.in[i] = a.in[i];
    C.out = a.out; C.ws = a.ws;
}
__global__ void __launch_bounds__(512, 2) mega_fwd(Args a) {
    extern __shared__ __attribute__((aligned(16))) unsigned char lds[];
    Ctx C; make_ctx(C, a, lds);
    volatile LAS unsigned* MISC = (volatile LAS unsigned*)(C.lds + MISC_OFF);
    if (C.tid < 64) MISC[C.tid] = 0u;
    __syncthreads();
    XcdBarrier bar = xcd_barrier_post((unsigned*)(a.ws + WS_CTL + CTL_BAR), MISC + 8);
#define GRID_BAR() do { unsigned* bp_ = (unsigned*)(a.ws + WS_CTL + CTL_BAR); unsigned x_ = bar.x; asm volatile("" : "+s"(bp_), "+s"(x_)); bar.bar = bp_; bar.x = x_; xcd_barrier(bar); } while (0)
    ph_prologue(C);
    GRID_BAR();
    for (int l = 0; l < DEPTH; ++l) {
        ph_inproj(C, l);
        GRID_BAR();
        ph_mixers(C, l);
        GRID_BAR();
        ph_merge(C, l);
        GRID_BAR();
        ph_out(C, l);
        GRID_BAR();
        ph_up(C, l);
        GRID_BAR();
        ph_down(C, l);
        if (l + 1 < DEPTH) GRID_BAR();
    }
}

extern "C" void kernel_launch(void* const* d_in, const int* in_sizes, int n_in, void* d_out, int out_size, void* d_ws, size_t ws_size, hipStream_t stream) {
    static int grid = 0;
    if (grid == 0) {
        if (n_in != 21 || in_sizes[0] != M_TOK * D_MODEL || out_size != M_TOK * D_MODEL || ws_size < WS_END2) { fprintf(stderr, "kernel_launch: unexpected shapes (n_in %d, ws %zu < %zu); nothing launched\n", n_in, ws_size, (size_t)WS_END); grid = -1; return; }
        int dev = 0, cus = 0, per_cu = 0;
        if (hipGetDevice(&dev) != hipSuccess || hipDeviceGetAttribute(&cus, hipDeviceAttributeMultiprocessorCount, dev) != hipSuccess) { fprintf(stderr, "kernel_launch: device query failed\n"); grid = -1; return; }
        if (hipFuncSetAttribute((const void*)mega_fwd, hipFuncAttributeMaxDynamicSharedMemorySize, LDS_BYTES) != hipSuccess) { fprintf(stderr, "kernel_launch: hipFuncSetAttribute failed\n"); grid = -1; return; }
        if (hipOccupancyMaxActiveBlocksPerMultiprocessor(&per_cu, (const void*)mega_fwd, NWAVES * 64, LDS_BYTES) != hipSuccess || per_cu < 1) fprintf(stderr, "kernel_launch: note: occupancy query reports %d workgroups per CU\n", per_cu);
        (void)hipGetLastError();
        if (cus != 256) fprintf(stderr, "kernel_launch: note: %d CUs; this kernel is laid out for 256 workgroups (one per CU of a 256-CU device)\n", cus);
        grid = 256;
    }
    if (grid < 0) return;
    if (hipMemsetAsync((char*)d_ws + WS_CTL, 0, CTL_ZERO_BYTES, stream) != hipSuccess) { fprintf(stderr, "kernel_launch: memset failed\n"); return; }
    Args a{};
    for (int i = 0; i < 21; ++i) a.in[i] = (const float*)d_in[i];
    a.out = (float*)d_out; a.ws = (unsigned char*)d_ws; a.l = 0; a.pad = 0;
    hipLaunchKernelGGL(mega_fwd, dim3(grid), dim3(NWAVES * 64), LDS_BYTES, stream, a);
    const hipError_t le = hipPeekAtLastError();
    if (le != hipSuccess) fprintf(stderr, "kernel_launch: launch failed: %s\n", hipGetErrorName(le));
}
```

```cpp
#include <hip/hip_runtime.h>
#include <cstdio>
#include <cstdint>

constexpr int D_MODEL = 2048, BATCH = 2, SEQ = 4096, DEPTH = 4;
constexpr int NH = 8, HD = 128, ATTN_W = NH * HD;
constexpr int MBLK = 256, TOPK = 3, NBLK = SEQ / MBLK;
constexpr int LRU_W = 1024, LRU_G = 8, LRU_BW = 128, SC_W = 1024;
constexpr int D_FF = 8192, N_IN = 14336, M_TOK = BATCH * SEQ;
constexpr float EPS = 1e-6f;
constexpr int SEG_Q = 0, SEG_K = 1, SEG_V = 2, SEG_XR = 3, SEG_GR = 4, SEG_SCB = 5, SEG_SCC = 6, SEG_SCX = 7;
constexpr int NGATE = 3 * D_MODEL;

constexpr size_t MiB = 1u << 20;
constexpr size_t WS_CTL = 0, CTL_ZERO_BYTES = 4 * MiB;
constexpr size_t CTL_KM = 1 * MiB;
constexpr size_t KM_LAYER_BYTES = (size_t)BATCH * NH * NBLK * HD * 4;
constexpr size_t WS_SSA = 4 * MiB, WS_SSB = 5 * MiB;
constexpr size_t WS_LRUS = 6 * MiB;
constexpr size_t WS_W = 8 * MiB;
constexpr size_t W_IN_B = (size_t)N_IN * D_MODEL * 2, W_ABC_B = (size_t)3 * D_MODEL * 1024 * 2, W_OUT_B = (size_t)D_MODEL * D_MODEL * 2, W_UP_B = (size_t)D_FF * D_MODEL * 2, W_DN_B = (size_t)D_MODEL * D_FF * 2;
constexpr size_t W_LAYER_B = W_IN_B + W_ABC_B + W_OUT_B + W_UP_B + W_DN_B;
constexpr size_t WS_XB = WS_W + DEPTH * W_LAYER_B;
constexpr size_t WS_SEG = WS_XB + (size_t)M_TOK * D_MODEL * 2;
constexpr size_t SEG_B = (size_t)M_TOK * 1024 * 2;
constexpr size_t WS_GATES = WS_SEG + 8 * SEG_B;
constexpr size_t WS_HID = WS_SEG;
constexpr size_t WS_ABC = WS_GATES + (size_t)M_TOK * NGATE * 2;
constexpr size_t WS_MB = WS_ABC + 3 * SEG_B;
constexpr size_t WS_END = WS_MB + (size_t)M_TOK * D_MODEL * 2;
static_assert(WS_HID + (size_t)M_TOK * D_FF * 2 <= WS_ABC, "hidden overlay");

#define GAS __attribute__((address_space(1)))
#define LAS __attribute__((address_space(3)))
typedef unsigned short bf16;
typedef unsigned v4u __attribute__((ext_vector_type(4)));
typedef unsigned v2u __attribute__((ext_vector_type(2)));
#define LDS_WAIT() asm volatile("s_waitcnt lgkmcnt(0)" ::: "memory")
#define VM_WAIT() asm volatile("s_waitcnt vmcnt(0)" ::: "memory")
__device__ __forceinline__ unsigned f2bf(float f) { unsigned u = __builtin_bit_cast(unsigned, f); return (u + 0x7fffu + ((u >> 16) & 1u)) >> 16; }
__device__ __forceinline__ unsigned pk2(float lo, float hi) { return f2bf(lo) | (f2bf(hi) << 16); }
__device__ __forceinline__ float bf2f(unsigned b) { return __builtin_bit_cast(float, b << 16); }
__device__ __forceinline__ float bflo(unsigned w) { return __builtin_bit_cast(float, w << 16); }
__device__ __forceinline__ float bfhi(unsigned w) { return __builtin_bit_cast(float, w & 0xffff0000u); }
__device__ __forceinline__ float bperm(float v, int src_lane) { return __builtin_bit_cast(float, __builtin_amdgcn_ds_bpermute(src_lane << 2, __builtin_bit_cast(int, v))); }
__device__ __forceinline__ float wave_sum(float v, int lane) {
#pragma unroll
    for (int o = 1; o < 64; o <<= 1) v += bperm(v, lane ^ o);
    return v;
}
__device__ __forceinline__ float fast_sigmoid(float x) { return __builtin_amdgcn_rcpf(1.f + __builtin_amdgcn_exp2f(-1.4426950408889634f * x)); }
__device__ __forceinline__ float sigmoidf_(float x) { return 1.f / (1.f + expf(-x)); }
__device__ __forceinline__ float gelu_tanh(float x) { return 0.5f * x * (1.f + tanhf(0.7978845608028654f * (x + 0.044715f * x * x * x))); }
__device__ __forceinline__ float row_rstd(const float* ss, int row) {
    typedef float f4 __attribute__((ext_vector_type(4)));
    const f4 a = *(const f4*)(ss + (size_t)row * 8), b = *(const f4*)(ss + (size_t)row * 8 + 4);
    const float s = ((a[0] + a[1]) + (a[2] + a[3])) + ((b[0] + b[1]) + (b[2] + b[3]));
    return rsqrtf(s * (1.f / D_MODEL) + EPS);
}
namespace pg8 {
#define PG8_LAS __attribute__((address_space(3)))
typedef unsigned short bf16_t;
typedef short bf16x8 __attribute__((ext_vector_type(8)));
typedef float f32x4 __attribute__((ext_vector_type(4)));
typedef unsigned u32x4 __attribute__((ext_vector_type(4)));
constexpr int BM = 256, BK = 64, HALF = 128, HTB = HALF * BK * 2  , STAGE_BYTES = 8 * HTB, NXCD = 8, WGM = 8;

__host__ __device__ __forceinline__ int lds_byte(int r, int c) { const int st = (r >> 4) * 2 + (c >> 5), rr = r & 15, cc = c & 31, ob = rr * 64 + cc * 2; return st * 1024 + (ob ^ (((ob >> 9) & 1) << 5)); }
__host__ __device__ __forceinline__ void stage_rc(int b, int& R, int& C) { const int st = b / 1024, sb = b % 1024, swz = sb ^ (((sb >> 9) & 1) << 5); R = (st >> 1) * 16 + swz / 64; C = (st & 1) * 32 + (swz % 64) / 2; }
__host__ __device__ __forceinline__ int perm32(int rho) { const int n = rho >> 4, i = rho & 15; return 8 * (i >> 2) + 4 * n + (i & 3); }

struct Unit { int pm, pn; };
struct Gemm { const bf16_t* A; const bf16_t* Bt; int M, N, K; };

struct StaticOrder {
    int nM, nN, nwg, G, c;
    __host__ __device__ void init(int M, int N, int G_, int c_) { nM = M / BM; nN = N / BM; nwg = nM * nN; G = G_; c = c_; }
    __host__ __device__ bool next(int i, Unit& u) const {
        const long L = (long)i * G + c; if (L >= nwg) return false;
        int wgid = (int)L; { const int q = nwg / NXCD, r = nwg % NXCD, xcd = wgid % NXCD, off = wgid / NXCD; wgid = (xcd < r ? xcd * (q + 1) : r * (q + 1) + (xcd - r) * q) + off; }
        const int nig = WGM * nN, gid = wgid / nig, fm = gid * WGM, gsz = (nM - fm) < WGM ? (nM - fm) : WGM;
        u.pm = fm + ((wgid % nig) % gsz); u.pn = (wgid % nig) / gsz; return true;
    }
    __device__ __forceinline__ void a_ready(const Unit&) const {}
    __device__ __forceinline__ void done(const Unit&) const {}
};
typedef float f32x2_t __attribute__((ext_vector_type(2))); typedef __bf16 bf16x2_t __attribute__((ext_vector_type(2)));
__device__ __forceinline__ unsigned cvt_pk_bf16(float lo, float hi) { f32x2_t v = {lo, hi}; bf16x2_t b = __builtin_convertvector(v, bf16x2_t); return __builtin_bit_cast(unsigned, b); }
typedef unsigned u32x2 __attribute__((ext_vector_type(2)));
__device__ __forceinline__ u32x4 pack8(const f32x4 v0, const f32x4 v1) { u32x4 w; w.x = cvt_pk_bf16(v0[0], v0[1]); w.y = cvt_pk_bf16(v0[2], v0[3]); w.z = cvt_pk_bf16(v1[0], v1[1]); w.w = cvt_pk_bf16(v1[2], v1[3]); return w; }
__device__ __forceinline__ void unpack8(const u32x4 w, f32x4& v0, f32x4& v1) {
    v0[0] = __builtin_bit_cast(float, w.x << 16); v0[1] = __builtin_bit_cast(float, w.x & 0xffff0000u); v0[2] = __builtin_bit_cast(float, w.y << 16); v0[3] = __builtin_bit_cast(float, w.y & 0xffff0000u);
    v1[0] = __builtin_bit_cast(float, w.z << 16); v1[1] = __builtin_bit_cast(float, w.z & 0xffff0000u); v1[2] = __builtin_bit_cast(float, w.w << 16); v1[3] = __builtin_bit_cast(float, w.w & 0xffff0000u);
}
__device__ __forceinline__ float rstd_of(const float* ss, int row) {
    const f32x4 a = *(const f32x4*)(ss + (size_t)row * 8), b = *(const f32x4*)(ss + (size_t)row * 8 + 4);
    const float s = ((a[0] + a[1]) + (a[2] + a[3])) + ((b[0] + b[1]) + (b[2] + b[3]));
    return __builtin_amdgcn_rsqf(s * (1.f / 2048.f) + 1e-6f);
}
__device__ __forceinline__ float sigm(float x) { return __builtin_amdgcn_rcpf(1.f + __builtin_amdgcn_exp2f(-1.4426950408889634f * x)); }

struct EpiProj {
    static constexpr bool PERM = true, AFTER_DRAIN = false, CHAIN = false;
    bf16_t* seg; bf16_t* gates; const PG8_LAS float* rs_lds; const float* gate_b; float* kmsum;
    __device__ __forceinline__ bool zero_after(const Unit&) const { return true; }
    __device__ __forceinline__ void operator()(const f32x4 (&acc)[2][2][4][2], const Unit& u, int wr, int wc, int fr, int fq) const {
        const int row0 = u.pm * BM + wr * 64 + fr;
        float rs[2][4];
#pragma unroll
        for (int ai = 0; ai < 2; ++ai)
#pragma unroll
            for (int m = 0; m < 4; ++m) rs[ai][m] = rs_lds[ai * HALF + wr * 64 + m * 16 + fr];
        if (u.pn < 32) {
            const int sg = u.pn >> 2, col0 = (u.pn & 3) * BM + wc * 32 + 8 * fq;
            bf16_t* base = seg + (size_t)sg * 8192 * 1024;
#pragma unroll
            for (int ai = 0; ai < 2; ++ai)
#pragma unroll
                for (int m = 0; m < 4; ++m) { bf16_t* rowp = base + (size_t)(row0 + ai * HALF + m * 16) * 1024 + col0; const float r = rs[ai][m];
#pragma unroll
                    for (int bj = 0; bj < 2; ++bj) *(u32x4*)(rowp + bj * HALF) = pack8(acc[ai][bj][m][0] * r, acc[ai][bj][m][1] * r); }
            if (sg == 1) {
                const int b = u.pm >> 4, blk = u.pm & 15;
#pragma unroll
                for (int bj = 0; bj < 2; ++bj)
#pragma unroll
                    for (int n = 0; n < 2; ++n) {
                        f32x4 s = (f32x4){0.f, 0.f, 0.f, 0.f};
#pragma unroll
                        for (int ai = 0; ai < 2; ++ai)
#pragma unroll
                            for (int m = 0; m < 4; ++m) s += acc[ai][bj][m][n] * rs[ai][m];
#pragma unroll
                        for (int j = 0; j < 4; ++j) { float v = s[j]; const int ln = fq * 16 + fr; v += bperm(v, ln ^ 1); v += bperm(v, ln ^ 2); v += bperm(v, ln ^ 4); v += bperm(v, ln ^ 8); s[j] = v; }
                        if (fr == 0) { const int c = col0 + bj * HALF + 4 * n; const int h = c >> 7, d = c & 127; float* p = kmsum + ((size_t)((b * 8 + h) * 16 + blk)) * 128 + d;
#pragma unroll
                            for (int j = 0; j < 4; ++j) atomicAdd(p + j, s[j]); }
                    }
            }
        } else {
            const int gcol0 = (u.pn - 32) * BM + wc * 32 + 8 * fq;
            constexpr float NL2E = -1.4426950408889634f, MAGIC = 8388608.f;
            f32x4 bv[2][2];
#pragma unroll
            for (int bj = 0; bj < 2; ++bj)
#pragma unroll
                for (int n = 0; n < 2; ++n) bv[bj][n] = *(const f32x4*)(gate_b + gcol0 + bj * HALF + 4 * n) * NL2E;
#pragma unroll
            for (int ai = 0; ai < 2; ++ai)
#pragma unroll
                for (int m = 0; m < 4; ++m) { unsigned char* rowp = (unsigned char*)gates + (size_t)(row0 + ai * HALF + m * 16) * 6144 + gcol0; const float r = rs[ai][m] * NL2E;
#pragma unroll
                    for (int bj = 0; bj < 2; ++bj) { u32x2 w;
#pragma unroll
                        for (int n = 0; n < 2; ++n) { const f32x4 t = acc[ai][bj][m][n] * r + bv[bj][n]; f32x4 e, z;
#pragma unroll
                            for (int j = 0; j < 4; ++j) e[j] = __builtin_amdgcn_exp2f(t[j]);
                            const f32x4 y = e * (1.f / 256.f) + (1.f / 256.f);
#pragma unroll
                            for (int j = 0; j < 4; ++j) z[j] = __builtin_amdgcn_rcpf(y[j]);
                            const f32x4 s = z + MAGIC; unsigned qb[4];
#pragma unroll
                            for (int j = 0; j < 4; ++j) qb[j] = __builtin_bit_cast(unsigned, __builtin_amdgcn_fmed3f(s[j], MAGIC + 1.f, MAGIC + 255.f));
                            const unsigned lo = __builtin_amdgcn_perm(qb[1], qb[0], 0x0c0c0400u), hi = __builtin_amdgcn_perm(qb[3], qb[2], 0x0c0c0400u);
                            w[n] = __builtin_amdgcn_perm(hi, lo, 0x05040100u); }
                        *(u32x2*)(rowp + bj * HALF) = w; } }
        }
    }
};

struct EpiMerge {
    static constexpr bool PERM = true, AFTER_DRAIN = false, CHAIN = true;
    const unsigned char* gates; bf16_t* mb;
    __device__ __forceinline__ bool zero_after(const Unit& u) const { return (u.pm >> 5) == 2; }
    __device__ __forceinline__ static void unq(const u32x2 w, f32x4& g0, f32x4& g1) {
        g0[0] = (float)(w.x & 0xffu); g0[1] = (float)((w.x >> 8) & 0xffu); g0[2] = (float)((w.x >> 16) & 0xffu); g0[3] = (float)(w.x >> 24);
        g1[0] = (float)(w.y & 0xffu); g1[1] = (float)((w.y >> 8) & 0xffu); g1[2] = (float)((w.y >> 16) & 0xffu); g1[3] = (float)(w.y >> 24); }
    __device__ __forceinline__ void operator()(f32x4 (&acc)[2][2][4][2], const Unit& u, int wr, int wc, int fr, int fq) const {
        const int br = u.pm >> 5, pm = u.pm & 31, pn = u.pn & 7;
        const int row0 = pm * BM + wr * 64 + fr, col0 = pn * BM + wc * 32 + 8 * fq;
#pragma unroll
        for (int ai = 0; ai < 2; ++ai)
#pragma unroll
            for (int m = 0; m < 4; ++m) { const size_t r = (size_t)(row0 + ai * HALF + m * 16);
#pragma unroll
                for (int bj = 0; bj < 2; ++bj) {
                    const unsigned char* gp = gates + r * 6144 + br * 2048 + col0 + bj * HALF;
                    f32x4 g0, g1; unq(*(const u32x2*)gp, g0, g1);
                    if (br < 2) { f32x4 h0, h1; unq(*(const u32x2*)(gp + 2048), h0, h1);
#pragma unroll
                        for (int j = 0; j < 4; ++j) { g0[j] *= __builtin_amdgcn_rcpf(h0[j]); g1[j] *= __builtin_amdgcn_rcpf(h1[j]); }
                        acc[ai][bj][m][0] *= g0; acc[ai][bj][m][1] *= g1;
                    } else *(u32x4*)(mb + r * 2048 + col0 + bj * HALF) = pack8(acc[ai][bj][m][0] * (g0 * (1.f / 256.f)), acc[ai][bj][m][1] * (g1 * (1.f / 256.f)));
                } }
    }
};

struct EpiResid {
    static constexpr bool PERM = true, AFTER_DRAIN = true, CHAIN = false;
    bf16_t* xb; float* ssq;
    __device__ __forceinline__ bool zero_after(const Unit&) const { return true; }
    __device__ __forceinline__ void fused(f32x4 (&acc)[2][2][4][2], const Unit& u, int wr, int wc, int fr, int fq, PG8_LAS unsigned char* lds, int wid, int lane) const {
        PG8_LAS float* P = (PG8_LAS float*)lds;
        const int row0 = u.pm * BM + wr * 64 + fr, col0 = u.pn * BM + wc * 32 + 8 * fq;
#pragma unroll
        for (int ai = 0; ai < 2; ++ai)
#pragma unroll
            for (int m = 0; m < 4; ++m) { const int rl = ai * HALF + wr * 64 + m * 16 + fr; const size_t off = (size_t)(row0 + ai * HALF + m * 16) * 2048 + col0; float q = 0.f;
#pragma unroll
                for (int bj = 0; bj < 2; ++bj) { bf16_t* p = xb + off + bj * HALF; f32x4 o0, o1; unpack8(*(const u32x4*)p, o0, o1); const f32x4 v0 = o0 + acc[ai][bj][m][0], v1 = o1 + acc[ai][bj][m][1];
                    *(u32x4*)p = pack8(v0, v1);
                    q += (v0[0] * v0[0] + v0[1] * v0[1]) + (v0[2] * v0[2] + v0[3] * v0[3]) + (v1[0] * v1[0] + v1[1] * v1[1]) + (v1[2] * v1[2] + v1[3] * v1[3]); }
                q += bperm(q, lane ^ 16); q += bperm(q, lane ^ 32);
                if (fq == 0) P[rl * 4 + wc] = q; }
        asm volatile("s_waitcnt lgkmcnt(0)" ::: "memory"); __builtin_amdgcn_s_barrier(); asm volatile("" ::: "memory");
        const int t = wid * 64 + lane;
        if (t < 256) { const f32x4 p = *(const PG8_LAS f32x4*)(P + t * 4); ssq[(size_t)(u.pm * BM + t) * 8 + u.pn] = (p[0] + p[1]) + (p[2] + p[3]); }
    }
};

struct EpiResidFin {
    static constexpr bool PERM = true, AFTER_DRAIN = true, CHAIN = false;
    const bf16_t* xb; float* part; unsigned* cnt; const float* fg; float* out;
    __device__ __forceinline__ bool zero_after(const Unit&) const { return true; }
    __device__ __forceinline__ void fused(f32x4 (&acc)[2][2][4][2], const Unit& u, int wr, int wc, int fr, int fq, PG8_LAS unsigned char* lds, int wid, int lane) const {
        PG8_LAS float* P = (PG8_LAS float*)lds;
        PG8_LAS float* RS = (PG8_LAS float*)(lds + 4096);
        const int row0 = u.pm * BM + wr * 64 + fr, col0 = u.pn * BM + wc * 32 + 8 * fq;
#pragma unroll
        for (int ai = 0; ai < 2; ++ai)
#pragma unroll
            for (int m = 0; m < 4; ++m) { const int rl = ai * HALF + wr * 64 + m * 16 + fr; const size_t off = (size_t)(row0 + ai * HALF + m * 16) * 2048 + col0; float q = 0.f;
#pragma unroll
                for (int bj = 0; bj < 2; ++bj) { f32x4 o0, o1; unpack8(*(const u32x4*)(xb + off + bj * HALF), o0, o1); const f32x4 v0 = o0 + acc[ai][bj][m][0], v1 = o1 + acc[ai][bj][m][1];
                    acc[ai][bj][m][0] = v0; acc[ai][bj][m][1] = v1;
                    q += (v0[0] * v0[0] + v0[1] * v0[1]) + (v0[2] * v0[2] + v0[3] * v0[3]) + (v1[0] * v1[0] + v1[1] * v1[1]) + (v1[2] * v1[2] + v1[3] * v1[3]); }
                q += bperm(q, lane ^ 16); q += bperm(q, lane ^ 32);
                if (fq == 0) P[rl * 4 + wc] = q; }
        asm volatile("s_waitcnt lgkmcnt(0)" ::: "memory"); __builtin_amdgcn_s_barrier(); asm volatile("" ::: "memory");
        const int t = wid * 64 + lane;
        if (t < 256) { const f32x4 p = *(const PG8_LAS f32x4*)(P + t * 4); __hip_atomic_store(part + (size_t)(u.pm * BM + t) * 8 + u.pn, (p[0] + p[1]) + (p[2] + p[3]), __ATOMIC_RELAXED, __HIP_MEMORY_SCOPE_AGENT); }
        asm volatile("s_waitcnt vmcnt(0) lgkmcnt(0)" ::: "memory"); __builtin_amdgcn_s_barrier(); asm volatile("" ::: "memory");
        if (wid == 0) {
            if (lane == 0) { __hip_atomic_fetch_add(cnt + u.pm, 1u, __ATOMIC_RELAXED, __HIP_MEMORY_SCOPE_AGENT); unsigned spins = 0;
                while (__hip_atomic_load(cnt + u.pm, __ATOMIC_RELAXED, __HIP_MEMORY_SCOPE_AGENT) < 8u) { __builtin_amdgcn_s_sleep(2); if (++spins > (1u << 22)) break; } }
            __builtin_amdgcn_fence(__ATOMIC_ACQUIRE, "agent");
            asm volatile("s_waitcnt vmcnt(0)" ::: "memory");
        }
        asm volatile("s_waitcnt vmcnt(0) lgkmcnt(0)" ::: "memory"); __builtin_amdgcn_s_barrier(); asm volatile("" ::: "memory");
        if (t < 256) { float s = 0.f;
#pragma unroll
            for (int j = 0; j < 8; ++j) s += __hip_atomic_load(part + (size_t)(u.pm * BM + t) * 8 + j, __ATOMIC_RELAXED, __HIP_MEMORY_SCOPE_AGENT);
            RS[t] = __builtin_amdgcn_rsqf(s * (1.f / 2048.f) + 1e-6f); }
        asm volatile("s_waitcnt vmcnt(0) lgkmcnt(0)" ::: "memory"); __builtin_amdgcn_s_barrier(); asm volatile("" ::: "memory");
        f32x4 gv[2][2];
#pragma unroll
        for (int bj = 0; bj < 2; ++bj)
#pragma unroll
            for (int n = 0; n < 2; ++n) gv[bj][n] = *(const f32x4*)(fg + col0 + bj * HALF + 4 * n);
#pragma unroll
        for (int ai = 0; ai < 2; ++ai)
#pragma unroll
            for (int m = 0; m < 4; ++m) { const float r = RS[ai * HALF + wr * 64 + m * 16 + fr]; float* orow = out + (size_t)(row0 + ai * HALF + m * 16) * 2048 + col0;
#pragma unroll
                for (int bj = 0; bj < 2; ++bj) { *(f32x4*)(orow + bj * HALF) = acc[ai][bj][m][0] * r * gv[bj][0]; *(f32x4*)(orow + bj * HALF + 4) = acc[ai][bj][m][1] * r * gv[bj][1]; } }
    }
};

struct EpiUp {
    static constexpr bool PERM = true, AFTER_DRAIN = false, CHAIN = false;
    bf16_t* hid; const PG8_LAS float* rs_lds;
    __device__ __forceinline__ bool zero_after(const Unit&) const { return true; }
    __device__ __forceinline__ void operator()(const f32x4 (&acc)[2][2][4][2], const Unit& u, int wr, int wc, int fr, int fq) const {
        const int row0 = u.pm * BM + wr * 64 + fr, col0 = u.pn * BM + wc * 32 + 8 * fq;
#pragma unroll
        for (int ai = 0; ai < 2; ++ai)
#pragma unroll
            for (int m = 0; m < 4; ++m) { const int rl = ai * HALF + wr * 64 + m * 16 + fr; const float r = rs_lds[rl];
                bf16_t* rowp = hid + (((size_t)u.pm * 128 + (size_t)(4 * u.pn + (wc >> 1))) * 256 + rl) * 64 + (wc & 1) * 32 + 8 * fq;
#pragma unroll
                for (int bj = 0; bj < 2; ++bj) { f32x4 v0 = acc[ai][bj][m][0] * r, v1 = acc[ai][bj][m][1] * r;
#pragma unroll
                    for (int j = 0; j < 4; ++j) { const float a = fmaxf(v0[j], 0.f), b = fmaxf(v1[j], 0.f); v0[j] = a * a; v1[j] = b * b; }
                    *(u32x4*)(rowp + (size_t)bj * 2 * 256 * 64) = pack8(v0, v1); } }
    }
};

struct MergeOrder {
    StaticOrder base;
    __device__ void init(int G, int c) { base.init(8192, 2048, G, c); }
    __device__ bool next(int i, Unit& u) const { Unit t; if (!base.next(i / 3, t)) return false; const int br = i % 3; u.pm = br * 32 + t.pm; u.pn = br * 8 + t.pn; return true; }
    __device__ __forceinline__ void a_ready(const Unit&) const {}
    __device__ __forceinline__ void done(const Unit&) const {}
};
template <class Epi, class Sched, bool ALIGN_EPI = false, bool SP2 = false, bool AT = false, bool BT = false>
__device__ __forceinline__ void gemm_phase(PG8_LAS unsigned char* lds, const Gemm g, const Sched& S, const Epi& E, int tid_in) {
    int tid_l = tid_in; asm volatile("" : "+v"(tid_l));
    const int tid = tid_l, wid = __builtin_amdgcn_readfirstlane(tid >> 6), lane = tid & 63, wr = wid >> 2, wc = wid & 3, fr = lane & 15, fq = lane >> 4;
    const int K = g.K, nt = K / BK;
    unsigned voffA[2], voffB[2];
#pragma unroll
    for (int i = 0; i < 2; ++i) { int R, C; stage_rc(tid * 16 + i * 8192, R, C); const int Rb = Epi::PERM ? ((R & ~31) + perm32(R & 31)) : R;
        voffA[i] = AT ? (unsigned)(R * BK + C) * 2u : (unsigned)(R * K + C) * 2u; voffB[i] = BT ? (unsigned)(Rb * BK + C) * 2u : (unsigned)(Rb * K + C) * 2u; }
    const size_t kstepA = AT ? (size_t)(BM * BK * 2) : (size_t)(BK * 2), kstepB = BT ? (size_t)(BM * BK * 2) : (size_t)(BK * 2);
    const size_t hstepA = AT ? (size_t)(HALF * BK * 2) : (size_t)HALF * K * 2, hstepB = BT ? (size_t)(HALF * BK * 2) : (size_t)HALF * K * 2;
    const size_t tstepA = (size_t)BM * K * 2, tstepB = tstepA;
    const unsigned ldsw = (unsigned)wid * 1024u;
    const int aoff = lds_byte(wr * 64 + fr, fq * 8), boff = lds_byte(wc * 32 + fr, fq * 8);
#define PG8_SA(b, h) (((b) * 2 + (h)) * HTB)
#define PG8_SB(b, h) ((4 + (b) * 2 + (h)) * HTB)
#define PG8_STAGE(bufoff, gbase, voff) do { _Pragma("unroll") for (int _i = 0; _i < 2; ++_i) \
        __builtin_amdgcn_global_load_lds((const unsigned*)((const char*)(gbase) + (voff)[_i]), (PG8_LAS unsigned*)(lds + (bufoff) + ldsw + _i * 8192), 16, 0, 0); } while (0)
#define PG8_LDA(dst, b, h) do { _Pragma("unroll") for (int m = 0; m < 4; ++m) _Pragma("unroll") for (int k = 0; k < 2; ++k) dst[m][k] = *(const PG8_LAS bf16x8*)(lds + PG8_SA(b, h) + aoff + m * 2048 + k * 1024); } while (0)
#define PG8_LDB(dst, b, h) do { _Pragma("unroll") for (int n = 0; n < 2; ++n) _Pragma("unroll") for (int k = 0; k < 2; ++k) dst[n][k] = *(const PG8_LAS bf16x8*)(lds + PG8_SB(b, h) + boff + n * 2048 + k * 1024); } while (0)
#define PG8_MMA(ai, bj, At, Bt) do { __builtin_amdgcn_s_setprio(1); _Pragma("unroll") for (int m = 0; m < 4; ++m) _Pragma("unroll") for (int n = 0; n < 2; ++n) _Pragma("unroll") for (int k = 0; k < 2; ++k) \
        acc[ai][bj][m][n] = __builtin_amdgcn_mfma_f32_16x16x32_bf16(Bt[n][k], At[m][k], acc[ai][bj][m][n], 0, 0, 0); __builtin_amdgcn_s_setprio(0); } while (0)
#define PG8_WAIT_V(n) asm volatile("s_waitcnt vmcnt(" #n ")" ::: "memory")
#define PG8_WAIT_L(n) asm volatile("s_waitcnt lgkmcnt(" #n ")" ::: "memory")
#define PG8_BAR __builtin_amdgcn_s_barrier()
#define PG8_SCHED __builtin_amdgcn_sched_barrier(0)
    Unit cur, nxt; int ui = 0;
    if (!S.next(0, cur)) return;
    f32x4 acc[2][2][4][2];
#pragma unroll
    for (int a = 0; a < 2; ++a)
#pragma unroll
        for (int b = 0; b < 2; ++b)
#pragma unroll
            for (int m = 0; m < 4; ++m)
#pragma unroll
                for (int n = 0; n < 2; ++n) acc[a][b][m][n] = (f32x4){0.f, 0.f, 0.f, 0.f};
    bf16x8 At[4][2], B0[2][2], B1[2][2];
    const char* cA = (const char*)g.A + (size_t)cur.pm * tstepA; const char* cB = (const char*)g.Bt + (size_t)cur.pn * tstepB;
    S.a_ready(cur);
    if constexpr (SP2) {
        PG8_STAGE(PG8_SB(0, 0), cB, voffB); PG8_STAGE(PG8_SB(0, 1), cB + hstepB, voffB); PG8_STAGE(PG8_SA(0, 0), cA, voffA); PG8_STAGE(PG8_SA(0, 1), cA + hstepA, voffA);
        if (wr == 1) PG8_BAR;
        PG8_WAIT_V(2); PG8_BAR;
        PG8_STAGE(PG8_SB(1, 0), cB + kstepB, voffB); PG8_STAGE(PG8_SA(1, 0), cA + kstepA, voffA); PG8_STAGE(PG8_SB(1, 1), cB + hstepB + kstepB, voffB);
        PG8_WAIT_V(6); PG8_BAR;
    } else {
        PG8_STAGE(PG8_SB(0, 0), cB, voffB); PG8_STAGE(PG8_SA(0, 0), cA, voffA); PG8_STAGE(PG8_SB(0, 1), cB + hstepB, voffB); PG8_STAGE(PG8_SA(0, 1), cA + hstepA, voffA);
        if (wr == 1) PG8_BAR;
        PG8_WAIT_V(4); PG8_BAR;
        PG8_STAGE(PG8_SB(1, 0), cB + kstepB, voffB); PG8_STAGE(PG8_SA(1, 0), cA + kstepA, voffA); PG8_STAGE(PG8_SB(1, 1), cB + hstepB + kstepB, voffB);
        PG8_WAIT_V(6); PG8_BAR;
    }
    for (;;) {
        const bool has_next = S.next(ui + 1, nxt);
        const char* nA = has_next ? (const char*)g.A + (size_t)nxt.pm * tstepA : cA; const char* nB = has_next ? (const char*)g.Bt + (size_t)nxt.pn * tstepB : cB;
        for (int t = 0; t < nt; t += 2) {
            const bool last = (t == nt - 2);
            const char* a1 = cA + (size_t)(t + 1) * kstepA;
            const char* a2 = last ? nA : cA + (size_t)(t + 2) * kstepA; const char* b2 = last ? nB : cB + (size_t)(t + 2) * kstepB;
            const char* a3 = a2 + kstepA; const char* b3 = b2 + kstepB;
            if (last && has_next) S.a_ready(nxt);
            if constexpr (SP2) {
            PG8_LDB(B0, 0, 0); PG8_LDB(B1, 0, 1); PG8_SCHED; PG8_LDA(At, 0, 0); PG8_STAGE(PG8_SA(1, 1), a1 + hstepA, voffA);
            PG8_WAIT_V(8); PG8_WAIT_L(0); PG8_BAR; PG8_MMA(0, 0, At, B0); PG8_MMA(0, 1, At, B1); PG8_BAR; PG8_SCHED;
            PG8_LDA(At, 0, 1); PG8_STAGE(PG8_SB(0, 0), b2, voffB); PG8_STAGE(PG8_SB(0, 1), b2 + hstepB, voffB); PG8_STAGE(PG8_SA(0, 0), a2, voffA);
            PG8_WAIT_V(8); PG8_WAIT_L(0); PG8_BAR; PG8_MMA(1, 0, At, B0); PG8_MMA(1, 1, At, B1); PG8_BAR; PG8_SCHED;
            PG8_LDB(B0, 1, 0); PG8_LDB(B1, 1, 1); PG8_SCHED; PG8_LDA(At, 1, 0); PG8_STAGE(PG8_SA(0, 1), a2 + hstepA, voffA);
            PG8_WAIT_V(8); PG8_WAIT_L(0); PG8_BAR; PG8_MMA(0, 0, At, B0); PG8_MMA(0, 1, At, B1); PG8_BAR; PG8_SCHED;
            PG8_LDA(At, 1, 1); PG8_STAGE(PG8_SB(1, 0), b3, voffB); PG8_STAGE(PG8_SB(1, 1), b3 + hstepB, voffB); PG8_STAGE(PG8_SA(1, 0), a3, voffA);
            PG8_WAIT_V(8); PG8_WAIT_L(0); PG8_BAR; PG8_MMA(1, 0, At, B0); PG8_MMA(1, 1, At, B1); PG8_BAR; PG8_SCHED;
            } else {
            PG8_LDB(B0, 0, 0); PG8_SCHED; PG8_LDA(At, 0, 0); PG8_STAGE(PG8_SA(1, 1), a1 + hstepA, voffA);
            PG8_WAIT_L(8); PG8_BAR; PG8_WAIT_L(0); PG8_MMA(0, 0, At, B0); PG8_BAR; PG8_SCHED;
            PG8_LDB(B1, 0, 1); PG8_STAGE(PG8_SB(0, 0), b2, voffB);
            PG8_BAR; PG8_WAIT_L(0); PG8_MMA(0, 1, At, B1); PG8_BAR;
            PG8_LDA(At, 0, 1); PG8_STAGE(PG8_SA(0, 0), a2, voffA);
            PG8_BAR; PG8_WAIT_L(0); PG8_MMA(1, 0, At, B0); PG8_BAR; PG8_SCHED;
            PG8_STAGE(PG8_SB(0, 1), b2 + hstepB, voffB);
            PG8_WAIT_V(6); PG8_BAR; PG8_MMA(1, 1, At, B1); PG8_BAR;
            PG8_LDB(B0, 1, 0); PG8_SCHED; PG8_LDA(At, 1, 0); PG8_STAGE(PG8_SA(0, 1), a2 + hstepA, voffA);
            PG8_WAIT_L(8); PG8_BAR; PG8_WAIT_L(0); PG8_MMA(0, 0, At, B0); PG8_BAR; PG8_SCHED;
            PG8_LDB(B1, 1, 1); PG8_STAGE(PG8_SB(1, 0), b3, voffB);
            PG8_BAR; PG8_WAIT_L(0); PG8_MMA(0, 1, At, B1); PG8_BAR;
            PG8_LDA(At, 1, 1); PG8_STAGE(PG8_SA(1, 0), a3, voffA);
            PG8_BAR; PG8_WAIT_L(0); PG8_MMA(1, 0, At, B0); PG8_BAR; PG8_SCHED;
            PG8_STAGE(PG8_SB(1, 1), b3 + hstepB, voffB);
            PG8_WAIT_V(6); PG8_BAR; PG8_MMA(1, 1, At, B1); PG8_BAR;
            }
        }
        if constexpr (ALIGN_EPI) { if (wr == 0) PG8_BAR; }
        if constexpr (!Epi::AFTER_DRAIN) { E(acc, cur, wr, wc, fr, fq); S.done(cur); }
        if (!has_next) break;
        if (!Epi::CHAIN || E.zero_after(cur)) {
#pragma unroll
        for (int a = 0; a < 2; ++a)
#pragma unroll
            for (int b = 0; b < 2; ++b)
#pragma unroll
                for (int m = 0; m < 4; ++m)
#pragma unroll
                    for (int n = 0; n < 2; ++n) acc[a][b][m][n] = (f32x4){0.f, 0.f, 0.f, 0.f};
        }
        cur = nxt; cA = nA; cB = nB; ++ui;
        if constexpr (ALIGN_EPI) { if (wr == 1) PG8_BAR; }
    }
    PG8_WAIT_V(0);
    if constexpr (!ALIGN_EPI) { if (wr == 0) PG8_BAR; }
    PG8_BAR;
    if constexpr (Epi::AFTER_DRAIN) { E.fused(acc, cur, wr, wc, fr, fq, lds, wid, lane); S.done(cur); }
#undef PG8_SA
#undef PG8_SB
#undef PG8_STAGE
#undef PG8_LDA
#undef PG8_LDB
#undef PG8_MMA
#undef PG8_WAIT_V
#undef PG8_WAIT_L
#undef PG8_BAR
#undef PG8_SCHED
}
}

constexpr int RING_OFF = 0, RING_BYTES = 131072;
constexpr int LDS_BYTES = 151552;
constexpr int MISC_OFF = LDS_BYTES - 256;
constexpr int NWAVES = 8;

struct Args { const float* in[21]; float* out; unsigned char* ws; int l; int pad; };

struct Ctx {
    LAS unsigned char* lds;
    int tid, lane, wave, G, bid;
    const float* in[21]; float* out; unsigned char* ws;
    __device__ __forceinline__ bf16* w_in_t(int l) const { return (bf16*)(ws + WS_W + (size_t)l * W_LAYER_B); }
    __device__ __forceinline__ bf16* w_abc_t(int l) const { return (bf16*)(ws + WS_W + (size_t)l * W_LAYER_B + W_IN_B); }
    __device__ __forceinline__ bf16* w_out_t(int l) const { return (bf16*)(ws + WS_W + (size_t)l * W_LAYER_B + W_IN_B + W_ABC_B); }
    __device__ __forceinline__ bf16* w_up_t(int l) const { return (bf16*)(ws + WS_W + (size_t)l * W_LAYER_B + W_IN_B + W_ABC_B + W_OUT_B); }
    __device__ __forceinline__ bf16* w_dn_t(int l) const { return (bf16*)(ws + WS_W + (size_t)l * W_LAYER_B + W_IN_B + W_ABC_B + W_OUT_B + W_UP_B); }
    __device__ __forceinline__ bf16* xb() const { return (bf16*)(ws + WS_XB); }
    __device__ __forceinline__ bf16* seg(int s) const { return (bf16*)(ws + WS_SEG + (size_t)s * SEG_B); }
    __device__ __forceinline__ bf16* gates() const { return (bf16*)(ws + WS_GATES); }
    __device__ __forceinline__ bf16* hid() const { return (bf16*)(ws + WS_HID); }
    __device__ __forceinline__ bf16* abc(int b) const { return (bf16*)(ws + WS_ABC + (size_t)b * SEG_B); }
    __device__ __forceinline__ bf16* mb() const { return (bf16*)(ws + WS_MB); }
    __device__ __forceinline__ float* ssa() const { return (float*)(ws + WS_SSA); }
    __device__ __forceinline__ float* ssb() const { return (float*)(ws + WS_SSB); }
    __device__ __forceinline__ float* kmsum(int l) const { return (float*)(ws + WS_CTL + CTL_KM + (size_t)l * KM_LAYER_BYTES); }
};

__device__ __forceinline__ void relaunder(Ctx& C) { int w = C.wave, bb = C.bid; asm volatile("" : "+s"(w), "+s"(bb)); C.bid = bb;     unsigned z = 0u; asm volatile("" : "+v"(z));     int ln = (int)__builtin_amdgcn_mbcnt_hi(~0u, __builtin_amdgcn_mbcnt_lo(~0u, z)); asm volatile("" : "+v"(ln)); C.wave = w; C.lane = ln; C.tid = w * 64 + ln; }
constexpr int TR_PITCH = 65, TR_WAVE_BYTES = 64 * TR_PITCH * 4;
static_assert(8 * TR_WAVE_BYTES <= MISC_OFF, "transpose scratch below the control words");
__device__ __forceinline__ unsigned cvt2(float lo, float hi) { typedef float f2 __attribute__((ext_vector_type(2))); typedef __bf16 b2 __attribute__((ext_vector_type(2))); f2 v = {lo, hi}; b2 b = __builtin_convertvector(v, b2); return __builtin_bit_cast(unsigned, b); }
typedef float f4_t __attribute__((ext_vector_type(4)));
__device__ __forceinline__ void ti_load(f4_t (&v)[16], const float* __restrict__ W, int K, int N, int item, int lane) {
    const int kblk = K / 64, nb = item / kblk, kb = item % kblk, k0 = 64 * kb, n0 = 64 * nb;
    const int r = lane >> 4, q = lane & 15;
#pragma unroll
    for (int i = 0; i < 16; ++i) v[i] = *(const f4_t*)(W + (size_t)(k0 + 4 * i + r) * N + n0 + 4 * q);
}
__device__ __forceinline__ void wt_dest(bool tiled, int K, int nrow0, int k0, unsigned& base, int& pitch) {
    if (tiled) { base = ((unsigned)(nrow0 >> 8) * (unsigned)(K >> 6) + (unsigned)(k0 >> 6)) * 16384u + (unsigned)(nrow0 & 255) * 64u; pitch = 64; } else { base = (unsigned)nrow0 * (unsigned)K + (unsigned)k0; pitch = K; }
}
__device__ __forceinline__ void ti_finish(f4_t (&v)[16], const float* __restrict__ gain, int K, int N, bf16* WT, int row_off, LAS float* scr, int item, int lane, bool tiled = true) {
    const int kblk = K / 64, nb = item / kblk, kb = item % kblk, k0 = 64 * kb, n0 = 64 * nb;
    const int r = lane >> 4, q = lane & 15;
    if (gain) {
#pragma unroll
        for (int i = 0; i < 16; ++i) v[i] *= gain[k0 + 4 * i + r];
    }
#pragma unroll
    for (int i = 0; i < 16; ++i) { LAS float* d = scr + (4 * i + r) * TR_PITCH + 4 * q; d[0] = v[i][0]; d[1] = v[i][1]; d[2] = v[i][2]; d[3] = v[i][3]; }
    LDS_WAIT(); asm volatile("" ::: "memory");
    const int c = lane & 7; unsigned wbase; int wpitch; wt_dest(tiled, K, row_off + n0, k0, wbase, wpitch);
#pragma unroll
    for (int j = 0; j < 8; ++j) { const int n = (lane >> 3) + 8 * j; const LAS float* s = scr + (8 * c) * TR_PITCH + n;
        v4u o; o.x = cvt2(s[0 * TR_PITCH], s[1 * TR_PITCH]); o.y = cvt2(s[2 * TR_PITCH], s[3 * TR_PITCH]); o.z = cvt2(s[4 * TR_PITCH], s[5 * TR_PITCH]); o.w = cvt2(s[6 * TR_PITCH], s[7 * TR_PITCH]);
        *(v4u*)(WT + (size_t)(wbase + (unsigned)(n * wpitch + 8 * c))) = o; }
    LDS_WAIT(); asm volatile("" ::: "memory");
}
constexpr int I_IN = (D_MODEL / 64) * (N_IN / 64), I_B = (1024 / 64) * (D_MODEL / 64), I_OUT = (D_MODEL / 64) * (D_MODEL / 64), I_UP = (D_MODEL / 64) * (D_FF / 64), I_DN = (D_FF / 64) * (D_MODEL / 64);
constexpr int NIT = I_IN + 3 * I_B + I_OUT + I_UP + I_DN;
static_assert(NIT == 512 * 35, "the attention phase deals exactly 35 items to every 64 idle wave-tiles");
__device__ __forceinline__ void conv_load(const Ctx& C, int l, int r, f4_t (&v)[16], int lane) {
    if (r < I_IN) { ti_load(v, C.in[2] + (size_t)l * D_MODEL * N_IN, D_MODEL, N_IN, r, lane); return; } r -= I_IN;
    if (r < I_B) { ti_load(v, C.in[5] + (size_t)l * 1024 * D_MODEL, 1024, D_MODEL, r, lane); return; } r -= I_B;
    if (r < I_B) { ti_load(v, C.in[13] + (size_t)l * 1024 * D_MODEL, 1024, D_MODEL, r, lane); return; } r -= I_B;
    if (r < I_B) { ti_load(v, C.in[15] + (size_t)l * 1024 * D_MODEL, 1024, D_MODEL, r, lane); return; } r -= I_B;
    if (r < I_OUT) { ti_load(v, C.in[16] + (size_t)l * D_MODEL * D_MODEL, D_MODEL, D_MODEL, r, lane); return; } r -= I_OUT;
    if (r < I_UP) { ti_load(v, C.in[18] + (size_t)l * D_MODEL * D_FF, D_MODEL, D_FF, r, lane); return; } r -= I_UP;
    ti_load(v, C.in[19] + (size_t)l * D_FF * D_MODEL, D_FF, D_MODEL, r, lane);
}
__device__ __forceinline__ void conv_finish(const Ctx& C, int l, int r, f4_t (&v)[16], LAS float* scr, int lane) {
    if (r < I_IN) { ti_finish(v, C.in[1] + (size_t)l * D_MODEL, D_MODEL, N_IN, C.w_in_t(l), 0, scr, r, lane); return; } r -= I_IN;
    if (r < I_B) { ti_finish(v, nullptr, 1024, D_MODEL, C.w_abc_t(l), 0, scr, r, lane); return; } r -= I_B;
    if (r < I_B) { ti_finish(v, nullptr, 1024, D_MODEL, C.w_abc_t(l), 2048, scr, r, lane); return; } r -= I_B;
    if (r < I_B) { ti_finish(v, nullptr, 1024, D_MODEL, C.w_abc_t(l), 4096, scr, r, lane); return; } r -= I_B;
    if (r < I_OUT) { ti_finish(v, nullptr, D_MODEL, D_MODEL, C.w_out_t(l), 0, scr, r, lane); return; } r -= I_OUT;
    if (r < I_UP) { ti_finish(v, C.in[17] + (size_t)l * D_MODEL, D_MODEL, D_FF, C.w_up_t(l), 0, scr, r, lane); return; } r -= I_UP;
    ti_finish(v, nullptr, D_FF, D_MODEL, C.w_dn_t(l), 0, scr, r, lane, true);
}
struct ItemP { const float* W; bf16* WT; int K, N, row_off, gsel, item, tiled; };
__device__ __forceinline__ ItemP item_params(const Ctx& C, int l, int r) {
    ItemP P;
    if (r < I_IN) { P.W = C.in[2] + (size_t)l * D_MODEL * N_IN; P.WT = C.w_in_t(l); P.K = D_MODEL; P.N = N_IN; P.row_off = 0; P.gsel = 0; P.item = r; P.tiled = 1; return P; } r -= I_IN;
    if (r < I_B) { P.W = C.in[5] + (size_t)l * 1024 * D_MODEL; P.WT = C.w_abc_t(l); P.K = 1024; P.N = D_MODEL; P.row_off = 0; P.gsel = -1; P.item = r; P.tiled = 1; return P; } r -= I_B;
    if (r < I_B) { P.W = C.in[13] + (size_t)l * 1024 * D_MODEL; P.WT = C.w_abc_t(l); P.K = 1024; P.N = D_MODEL; P.row_off = 2048; P.gsel = -1; P.item = r; P.tiled = 1; return P; } r -= I_B;
    if (r < I_B) { P.W = C.in[15] + (size_t)l * 1024 * D_MODEL; P.WT = C.w_abc_t(l); P.K = 1024; P.N = D_MODEL; P.row_off = 4096; P.gsel = -1; P.item = r; P.tiled = 1; return P; } r -= I_B;
    if (r < I_OUT) { P.W = C.in[16] + (size_t)l * D_MODEL * D_MODEL; P.WT = C.w_out_t(l); P.K = D_MODEL; P.N = D_MODEL; P.row_off = 0; P.gsel = -1; P.item = r; P.tiled = 1; return P; } r -= I_OUT;
    if (r < I_UP) { P.W = C.in[18] + (size_t)l * D_MODEL * D_FF; P.WT = C.w_up_t(l); P.K = D_MODEL; P.N = D_FF; P.row_off = 0; P.gsel = D_MODEL; P.item = r; P.tiled = 1; return P; } r -= I_UP;
    P.W = C.in[19] + (size_t)l * D_FF * D_MODEL; P.WT = C.w_dn_t(l); P.K = D_FF; P.N = D_MODEL; P.row_off = 0; P.gsel = -1; P.item = r; P.tiled = 1; return P;
}
__device__ __forceinline__ void ti_load_asm(f4_t (&v)[16], const ItemP& P, int lane) {
    const int kblk = P.K / 64, nb = P.item / kblk, kb = P.item % kblk, k0 = 64 * kb, n0 = 64 * nb, r = lane >> 4, q = lane & 15;
    const float* p0 = P.W + (size_t)(k0 + 16 * r) * P.N + n0 + 4 * q; const size_t step = (size_t)P.N;
#pragma unroll
    for (int i = 0; i < 16; ++i) { const float* p = p0 + i * step; asm volatile("global_load_dwordx4 %0, %1, off" : "=v"(v[i]) : "v"(p) : "memory"); }
}
__device__ __forceinline__ void ti_finish_reg(f4_t (&v)[16], const ItemP& P, const LAS float* gtab, LAS unsigned char* scr, int lane) {
    const int kblk = P.K / 64, nb = P.item / kblk, kb = P.item % kblk, k0 = 64 * kb, n0 = 64 * nb, r = lane >> 4, q = lane & 15;
    if (P.gsel >= 0) { const LAS f4_t* gp = (const LAS f4_t*)(gtab + P.gsel + k0 + 16 * r);
#pragma unroll
        for (int u = 0; u < 4; ++u) { const f4_t g = gp[u]; v[4 * u] *= g[0]; v[4 * u + 1] *= g[1]; v[4 * u + 2] *= g[2]; v[4 * u + 3] *= g[3]; } }
#pragma unroll
    for (int c = 0; c < 4; ++c) {
        const v4u o0 = {cvt2(v[0][c], v[1][c]), cvt2(v[2][c], v[3][c]), cvt2(v[4][c], v[5][c]), cvt2(v[6][c], v[7][c])}, o1 = {cvt2(v[8][c], v[9][c]), cvt2(v[10][c], v[11][c]), cvt2(v[12][c], v[13][c]), cvt2(v[14][c], v[15][c])};
        LAS unsigned char* d = scr + (4 * q + c) * 144 + 32 * r; *(LAS v4u*)d = o0; *(LAS v4u*)(d + 16) = o1; }
    LDS_WAIT(); asm volatile("" ::: "memory");
    const int cc = lane & 7; unsigned wbase; int wpitch; wt_dest(P.tiled != 0, P.K, P.row_off + n0, k0, wbase, wpitch);
#pragma unroll
    for (int j = 0; j < 8; ++j) { const int n = (lane >> 3) + 8 * j; const v4u o = *(const LAS v4u*)(scr + n * 144 + 16 * cc);
        *(v4u*)(P.WT + (size_t)(wbase + (unsigned)(n * wpitch + 8 * cc))) = o; }
    LDS_WAIT(); asm volatile("" ::: "memory");
}
__device__ __forceinline__ void wait_vm_le(int n) {
    if (n >= 56) asm volatile("s_waitcnt vmcnt(56)" ::: "memory"); else if (n >= 48) asm volatile("s_waitcnt vmcnt(48)" ::: "memory"); else if (n >= 40) asm volatile("s_waitcnt vmcnt(40)" ::: "memory");
    else if (n >= 32) asm volatile("s_waitcnt vmcnt(32)" ::: "memory"); else if (n >= 24) asm volatile("s_waitcnt vmcnt(24)" ::: "memory"); else if (n >= 16) asm volatile("s_waitcnt vmcnt(16)" ::: "memory");
    else if (n >= 8) asm volatile("s_waitcnt vmcnt(8)" ::: "memory"); else asm volatile("s_waitcnt vmcnt(0)" ::: "memory");
}
#define TI_TIE(v) asm volatile("" : "+v"(v[0]), "+v"(v[1]), "+v"(v[2]), "+v"(v[3]), "+v"(v[4]), "+v"(v[5]), "+v"(v[6]), "+v"(v[7]), "+v"(v[8]), "+v"(v[9]), "+v"(v[10]), "+v"(v[11]), "+v"(v[12]), "+v"(v[13]), "+v"(v[14]), "+v"(v[15]) :: "memory")
__device__ __forceinline__ void ph_prologue(Ctx& C) {
    relaunder(C);
    LAS float* scr = (LAS float*)(C.lds + C.wave * TR_WAVE_BYTES);
    const int gw = C.bid * NWAVES + C.wave, NGW = C.G * NWAVES;
    for (int it = gw; it < NIT; it += NGW) { f4_t v[16]; conv_load(C, 0, it, v, C.lane); conv_finish(C, 0, it, v, scr, C.lane); }
    typedef float f4 __attribute__((ext_vector_type(4)));
    for (int m = gw; m < M_TOK; m += NGW) {
        const f4* xr = (const f4*)(C.in[0] + (size_t)m * D_MODEL) + C.lane;
        unsigned long long* b8 = (unsigned long long*)(C.xb() + (size_t)m * D_MODEL) + C.lane;
        float part[8];
#pragma unroll
        for (int j = 0; j < 8; ++j) { const f4 v = xr[64 * j]; b8[64 * j] = (unsigned long long)cvt2(v[0], v[1]) | ((unsigned long long)cvt2(v[2], v[3]) << 32);
            part[j] = wave_sum((v[0] * v[0] + v[1] * v[1]) + (v[2] * v[2] + v[3] * v[3]), C.lane); }
        if (C.lane == 0) { float* sp = C.ssa() + (size_t)m * 8;
#pragma unroll
            for (int j = 0; j < 8; ++j) sp[j] = part[j]; }
    }
}
constexpr int RS_OFF = RING_BYTES;
__device__ __forceinline__ const LAS float* stage_rstd(Ctx& C, const float* ss, int M, int N) {
    pg8::StaticOrder S; S.init(M, N, C.G, C.bid); pg8::Unit u0; S.next(0, u0);
    LAS float* t = (LAS float*)(C.lds + RS_OFF);
    if (C.tid < 256) t[C.tid] = row_rstd(ss, u0.pm * 256 + C.tid);
    asm volatile("s_waitcnt vmcnt(0) lgkmcnt(0)" ::: "memory"); __builtin_amdgcn_s_barrier(); asm volatile("" ::: "memory");
    return t;
}
__device__ __forceinline__ void ph_inproj(Ctx& C, int l) {
    relaunder(C);
    pg8::Gemm g{C.xb(), C.w_in_t(l), M_TOK, N_IN, D_MODEL}; pg8::StaticOrder S; S.init(M_TOK, N_IN, C.G, C.bid);
    pg8::EpiProj E{C.seg(0), C.gates(), stage_rstd(C, C.ssa(), M_TOK, N_IN), C.in[3] + (size_t)l * NGATE, C.kmsum(l)};
    pg8::gemm_phase<pg8::EpiProj, pg8::StaticOrder, true, true, false, true>(C.lds + RING_OFF, g, S, E, C.tid);
}
__device__ __forceinline__ void ph_merge(Ctx& C, int l) {
    relaunder(C);
    pg8::Gemm g{C.abc(0), C.w_abc_t(l), 3 * M_TOK, 3 * D_MODEL, 1024}; pg8::MergeOrder S; S.init(C.G, C.bid);
    pg8::EpiMerge E{(const unsigned char*)C.gates(), C.mb()};
    pg8::gemm_phase<pg8::EpiMerge, pg8::MergeOrder, true, true, false, true>(C.lds + RING_OFF, g, S, E, C.tid);
}
__device__ __forceinline__ void ph_out(Ctx& C, int l) {
    relaunder(C);
    pg8::Gemm g{C.mb(), C.w_out_t(l), M_TOK, D_MODEL, D_MODEL}; pg8::StaticOrder S; S.init(M_TOK, D_MODEL, C.G, C.bid);
    pg8::EpiResid E{C.xb(), C.ssb()};
    pg8::gemm_phase<pg8::EpiResid, pg8::StaticOrder, false, true, false, true>(C.lds + RING_OFF, g, S, E, C.tid);
}
__device__ __forceinline__ void ph_up(Ctx& C, int l) {
    relaunder(C);
    pg8::Gemm g{C.xb(), C.w_up_t(l), M_TOK, D_FF, D_MODEL}; pg8::StaticOrder S; S.init(M_TOK, D_FF, C.G, C.bid);
    pg8::EpiUp E{C.hid(), stage_rstd(C, C.ssb(), M_TOK, D_FF)};
    pg8::gemm_phase<pg8::EpiUp, pg8::StaticOrder, true, true, false, true>(C.lds + RING_OFF, g, S, E, C.tid);
}
constexpr size_t CTL_FINC = 3 * MiB + 512 * 1024;
__device__ __forceinline__ void ph_down(Ctx& C, int l) {
    relaunder(C);
    pg8::Gemm g{C.hid(), C.w_dn_t(l), M_TOK, D_MODEL, D_FF};     pg8::StaticOrder S; S.init(M_TOK, D_MODEL, C.G, C.bid);
    if (l + 1 < DEPTH) { pg8::EpiResid E{C.xb(), C.ssa()};
        pg8::gemm_phase<pg8::EpiResid, pg8::StaticOrder, false, true, true, true>(C.lds + RING_OFF, g, S, E, C.tid); }
    else { pg8::EpiResidFin E{C.xb(), C.ssb(), (unsigned*)(C.ws + WS_CTL + CTL_FINC), C.in[20], C.out};
        pg8::gemm_phase<pg8::EpiResidFin, pg8::StaticOrder, false, true, true, true>(C.lds + RING_OFF, g, S, E, C.tid); }
}
typedef short bf16x8_t __attribute__((ext_vector_type(8)));
typedef short s16x4_t __attribute__((ext_vector_type(4)));
typedef float f32x16_t __attribute__((ext_vector_type(16)));
typedef float f32x4_t __attribute__((ext_vector_type(4)));
__device__ __forceinline__ unsigned cvtpk(float lo, float hi) { typedef float f2 __attribute__((ext_vector_type(2))); typedef __bf16 b2 __attribute__((ext_vector_type(2))); f2 v = {lo, hi}; b2 b = __builtin_convertvector(v, b2); return __builtin_bit_cast(unsigned, b); }
__device__ __forceinline__ s16x4_t lds_tr(LAS const unsigned char* p) { return __builtin_bit_cast(s16x4_t, __builtin_amdgcn_ds_read_tr16_b64_v4i16((LAS s16x4_t*)p)); }
__device__ __forceinline__ int t5_bucket(int n) {
    if (n < 16) return n;
    const int large = 16 + (int)(logf((float)n / 16.f) / 2.0794415416798357f * 16.f);
    return large < 31 ? large : 31;
}
__device__ __forceinline__ float xhalf_max(float x) { float a = x, b = x; asm volatile("v_nop\n\tv_nop\n\tv_permlane32_swap_b32 %0, %1" : "+v"(a), "+v"(b)); return fmaxf(a, b); }
__device__ __forceinline__ float xhalf_sum(float x) { float a = x, b = x; asm volatile("v_nop\n\tv_nop\n\tv_permlane32_swap_b32 %0, %1" : "+v"(a), "+v"(b)); return a + b; }
__device__ __forceinline__ unsigned off_b(unsigned row, unsigned ch) { return 256u * row + 16u * (ch ^ (((row & 3) << 2) | ((row >> 2) & 3))); }


template <int OFF> __device__ __forceinline__ void vtr_issue(s16x4_t (&r)[8], const unsigned (&a)[8]) {
    asm volatile("ds_read_b64_tr_b16 %0, %8 offset:%16\n\tds_read_b64_tr_b16 %1, %9 offset:%17\n\tds_read_b64_tr_b16 %2, %10 offset:%16\n\tds_read_b64_tr_b16 %3, %11 offset:%17\n\t"
                 "ds_read_b64_tr_b16 %4, %12 offset:%16\n\tds_read_b64_tr_b16 %5, %13 offset:%17\n\tds_read_b64_tr_b16 %6, %14 offset:%16\n\tds_read_b64_tr_b16 %7, %15 offset:%17"
                 : "=&v"(r[0]), "=&v"(r[1]), "=&v"(r[2]), "=&v"(r[3]), "=&v"(r[4]), "=&v"(r[5]), "=&v"(r[6]), "=&v"(r[7])
                 : "v"(a[0]), "v"(a[1]), "v"(a[2]), "v"(a[3]), "v"(a[4]), "v"(a[5]), "v"(a[6]), "v"(a[7]), "n"(OFF), "n"(OFF + 2048) : "memory");
}
__device__ __forceinline__ void vtr_wait(s16x4_t (&r)[8], s16x4_t (&q)[8]) {
    asm volatile("s_waitcnt lgkmcnt(0)" : "+v"(r[0]), "+v"(r[1]), "+v"(r[2]), "+v"(r[3]), "+v"(r[4]), "+v"(r[5]), "+v"(r[6]), "+v"(r[7]),
                 "+v"(q[0]), "+v"(q[1]), "+v"(q[2]), "+v"(q[3]), "+v"(q[4]), "+v"(q[5]), "+v"(q[6]), "+v"(q[7]) :: "memory");
}
__device__ __forceinline__ bf16x8_t vcat(const s16x4_t a, const s16x4_t b) { return (bf16x8_t){a[0], a[1], a[2], a[3], b[0], b[1], b[2], b[3]}; }
constexpr int AT_K0 = 0, AT_V0 = 16384, AT_BUF = 32768, AT_TB = 65536, AT_CONV = 66048, AT_GAIN = AT_CONV + 4 * TR_WAVE_BYTES;
static_assert(AT_GAIN + 2 * D_MODEL * 4 <= MISC_OFF, "conversion scratch and gain table below the control words");
constexpr float AT_NEG = -1e30f;
__device__ __forceinline__ void attn_stage(Ctx& C, const bf16* Kg, const bf16* Vg, int b, int h, int key0, int buf, bool tail = false) {
#pragma unroll
    for (int pi = 0; pi < 4; ++pi) {
        if (pi >= 2 && !tail) break;
        const int p = tail ? (C.wave & 3) * 4 + pi : C.wave * 2 + pi, row = 4 * p + (C.lane >> 4), cs = C.lane & 15, ch = cs ^ (((row & 3) << 2) | ((row >> 2) & 3));
        const size_t goff = ((size_t)(b * SEQ + key0 + row) * 1024 + h * HD) * 2 + ch * 16;
        __builtin_amdgcn_global_load_lds((const unsigned*)((const char*)Kg + goff), (LAS unsigned*)(C.lds + buf * AT_BUF + AT_K0 + p * 1024), 16, 0, 0);
        __builtin_amdgcn_global_load_lds((const unsigned*)((const char*)Vg + goff), (LAS unsigned*)(C.lds + buf * AT_BUF + AT_V0 + p * 1024), 16, 0, 0);
    }
}
__device__ __forceinline__ void ph_attention(Ctx& C, int l) {
    relaunder(C);
    const bf16* Qg = C.seg(SEG_Q); const bf16* Kg = C.seg(SEG_K); const bf16* Vg = C.seg(SEG_V); bf16* Og = C.abc(0);
    const float* kms = C.kmsum(l); const float* rel = C.in[4];
    const int bid = C.bid, bh = (bid & 7) * 2 + ((bid >> 3) & 1), widx = bid >> 4, b = bh >> 3, h = bh & 7, ii = widx >> 1, half = widx & 1;
    const int lane = C.lane, wave = C.wave, grp = wave >> 2, wq = wave & 3, hi = lane >> 5, l31 = lane & 31;
    const int nown = grp ? 15 - ii : ii;
    const int r0 = half * 128 + wq * 32;
    const int rq = r0 + l31;
    const int nB = 15 - ii, ntiles = nB * 4 + (half ? 4 : 2);
    const int TA = ii * 4 + (half ? 4 : 2);
    const int nt_w = grp ? ntiles : TA;
    constexpr float LOG2E = 1.4426950408889634f, SC = 0.08838834764831845f * 1.4426950408889634f;
    LAS float* tb = (LAS float*)(C.lds + AT_TB);
    if (C.tid < 128) tb[C.tid] = rel[t5_bucket(C.tid) * NH + h] * LOG2E;
    const float c31 = rel[31 * NH + h] * LOG2E;
    attn_stage(C, Kg, Vg, b, h, 0, 0);
    bf16x8_t qf[8];
    { const bf16* qp = Qg + (size_t)(b * SEQ + nown * 256 + rq) * 1024 + h * HD + 8 * hi;
#pragma unroll
      for (int s = 0; s < 8; ++s) qf[s] = *(const bf16x8_t*)(qp + 16 * s); }
    unsigned selmask;
    {
        f32x16_t ga = {0.f, 0.f, 0.f, 0.f, 0.f, 0.f, 0.f, 0.f, 0.f, 0.f, 0.f, 0.f, 0.f, 0.f, 0.f, 0.f};
        const float* kp = kms + ((size_t)(bh * 16 + (l31 & 15))) * 128 + 8 * hi;
#pragma unroll
        for (int s = 0; s < 8; ++s) {
            f32x4_t v0 = *(const f32x4_t*)(kp + 16 * s), v1 = *(const f32x4_t*)(kp + 16 * s + 4);
            if (l31 >= 16) { v0 = (f32x4_t){0.f, 0.f, 0.f, 0.f}; v1 = v0; }
            v0 *= (1.f / 256.f); v1 *= (1.f / 256.f);
            unsigned hw[4], lw[4];
            hw[0] = cvtpk(v0[0], v0[1]); hw[1] = cvtpk(v0[2], v0[3]); hw[2] = cvtpk(v1[0], v1[1]); hw[3] = cvtpk(v1[2], v1[3]);
            lw[0] = cvtpk(v0[0] - bflo(hw[0]), v0[1] - bfhi(hw[0])); lw[1] = cvtpk(v0[2] - bflo(hw[1]), v0[3] - bfhi(hw[1]));
            lw[2] = cvtpk(v1[0] - bflo(hw[2]), v1[1] - bfhi(hw[2])); lw[3] = cvtpk(v1[2] - bflo(hw[3]), v1[3] - bfhi(hw[3]));
            const v4u hv = {hw[0], hw[1], hw[2], hw[3]}, lv = {lw[0], lw[1], lw[2], lw[3]};
            ga = __builtin_amdgcn_mfma_f32_32x32x16_bf16(__builtin_bit_cast(bf16x8_t, hv), qf[s], ga, 0, 0, 0);
            ga = __builtin_amdgcn_mfma_f32_32x32x16_bf16(__builtin_bit_cast(bf16x8_t, lv), qf[s], ga, 0, 0, 0);
        }
        float G[16];
#pragma unroll
        for (int r = 0; r < 8; ++r) { const float own = ga[r], oth = bperm(own, lane ^ 32); const int nlo = (r & 3) + 8 * (r >> 2); G[nlo] = hi ? oth : own; G[nlo + 4] = hi ? own : oth; }
#pragma unroll
        for (int n = 0; n < 16; ++n) G[n] = (n < nown) ? G[n] : -INFINITY;
        selmask = 0u;
#pragma unroll
        for (int k = 0; k < TOPK; ++k) {
            float best = G[0]; int bi = 0;
#pragma unroll
            for (int n = 1; n < 16; ++n) { const bool bt = G[n] > best; best = bt ? G[n] : best; bi = bt ? n : bi; }
            selmask |= (best > -INFINITY) ? (1u << bi) : 0u;
#pragma unroll
            for (int n = 0; n < 16; ++n) G[n] = (n == bi) ? -INFINITY : G[n];
        }
    }
    f32x16_t o[4];
#pragma unroll
    for (int c = 0; c < 4; ++c) o[c] = (f32x16_t){0.f, 0.f, 0.f, 0.f, 0.f, 0.f, 0.f, 0.f, 0.f, 0.f, 0.f, 0.f, 0.f, 0.f, 0.f, 0.f};
    float mrow = AT_NEG, lrow = 0.f;
    const unsigned kbase = off_b(l31, hi);
    unsigned vbase; { const unsigned blk = (lane >> 4) & 1, q4 = (lane & 15) >> 2, p4 = lane & 3; vbase = off_b(4 * hi + q4, 2 * blk + (p4 >> 1)) + 8 * (p4 & 1); }
    unsigned vad[8];
    { const unsigned lb = (unsigned)(size_t)C.lds;
#pragma unroll
      for (int c = 0; c < 4; ++c) { vad[2 * c] = lb + (vbase ^ (unsigned)(c << 6)); vad[2 * c + 1] = lb + ((vbase ^ (unsigned)(c << 6)) ^ 32u); } }
typedef __bf16 bf16x2_at __attribute__((ext_vector_type(2)));
#ifndef ATTN_IDLE
#define ATTN_IDLE(IT) do { __builtin_amdgcn_s_barrier(); } while (0)
#endif
#define ATTN_TILE(IT, BUFC, FARC) do { const int it = (IT); constexpr int BUF = (BUFC); constexpr bool FARONLY = (FARC); \
        asm volatile("s_waitcnt vmcnt(0) lgkmcnt(0)" ::: "memory"); \
        __builtin_amdgcn_s_barrier(); \
        asm volatile("" ::: "memory"); \
        if (it + 1 < ntiles && it < TA) attn_stage(C, Kg, Vg, b, h, (it + 1) * 64, BUF ^ 1, false);     \
        const int j = it >> 2, k0 = (it & 3) * 64; \
        if (j > nown) break; \
        const bool own = (j == nown); \
        if (own && k0 > r0 + 31) break; \
        bool rowsel = true; \
        if (!own) { rowsel = (selmask >> j) & 1u; const unsigned long long bal = __ballot(rowsel); if (bal == 0ull) break; } \
        LAS const unsigned char* kb = C.lds + BUF * AT_BUF + AT_K0; \
        constexpr int VOFF = BUF * AT_BUF + AT_V0; \
        f32x16_t sa0 = {0.f, 0.f, 0.f, 0.f, 0.f, 0.f, 0.f, 0.f, 0.f, 0.f, 0.f, 0.f, 0.f, 0.f, 0.f, 0.f}, sa1 = sa0; \
        bf16x8_t kg[4][4]; \
        _Pragma("unroll") for (int g = 0; g < 2; ++g) _Pragma("unroll") for (int e = 0; e < 2; ++e) { const unsigned ka = kbase ^ (unsigned)((2 * g + e) << 5); kg[g][2 * e] = *(LAS const bf16x8_t*)(kb + ka); kg[g][2 * e + 1] = *(LAS const bf16x8_t*)(kb + 8192 + ka); } \
        __builtin_amdgcn_sched_barrier(0); \
        s16x4_t vr0[8], vr1[8]; \
        _Pragma("unroll") for (int g = 0; g < 4; ++g) { \
            if (g + 2 < 4) { _Pragma("unroll") for (int e = 0; e < 2; ++e) { const unsigned ka = kbase ^ (unsigned)((2 * (g + 2) + e) << 5); kg[g + 2][2 * e] = *(LAS const bf16x8_t*)(kb + ka); kg[g + 2][2 * e + 1] = *(LAS const bf16x8_t*)(kb + 8192 + ka); } } \
            __builtin_amdgcn_sched_barrier(0); \
            _Pragma("unroll") for (int e = 0; e < 2; ++e) { sa0 = __builtin_amdgcn_mfma_f32_32x32x16_bf16(kg[g][2 * e], qf[2 * g + e], sa0, 0, 0, 0); sa1 = __builtin_amdgcn_mfma_f32_32x32x16_bf16(kg[g][2 * e + 1], qf[2 * g + e], sa1, 0, 0, 0); } \
            if (g == 2) vtr_issue<VOFF>(vr0, vad); \
            if (g == 3) vtr_issue<VOFF + 4096>(vr1, vad); \
            __builtin_amdgcn_sched_barrier(0); \
        } \
        float pv[32]; \
        if constexpr (FARONLY) {                                          \
            float mr = fmaxf(sa0[0], sa1[0]); \
            _Pragma("unroll") for (int r = 1; r < 16; ++r) mr = fmaxf(fmaxf(mr, sa0[r]), sa1[r]); \
            float mx = xhalf_max(mr) * SC + c31; \
            if (!rowsel) mx = AT_NEG; \
            if (!__all(mx - mrow <= 8.0f)) { \
                const float mnew = fmaxf(mrow, mx), alpha = __builtin_amdgcn_exp2f(mrow - mnew); \
                mrow = mnew; lrow *= alpha; \
                _Pragma("unroll") for (int c = 0; c < 4; ++c) o[c] *= alpha; \
            } \
            const float off = rowsel ? c31 - mrow : AT_NEG;               \
            _Pragma("unroll") for (int r = 0; r < 16; ++r) { pv[r] = __builtin_amdgcn_exp2f(sa0[r] * SC + off); pv[16 + r] = __builtin_amdgcn_exp2f(sa1[r] * SC + off); } \
        } else { \
        const int mind = (nown - j) * 256 + r0 - (k0 + 63); \
        if (mind >= 113) { \
            _Pragma("unroll") for (int r = 0; r < 16; ++r) { pv[r] = sa0[r] * SC + c31; pv[16 + r] = sa1[r] * SC + c31; } \
        } else { \
            const int dbase = (nown - j) * 256 + rq - k0 - 4 * hi; \
            _Pragma("unroll") for (int r = 0; r < 32; ++r) { const int kr = (r & 3) + 8 * ((r & 15) >> 2) + 32 * (r >> 4); int d = dbase - kr; const bool masked = d < 0; d = d < 0 ? 0 : (d > 127 ? 127 : d); \
                const float sc = (r < 16 ? sa0[r & 15] : sa1[r & 15]) * SC + tb[d]; pv[r] = masked ? AT_NEG : sc; } \
        } \
        float mx = pv[0]; \
        _Pragma("unroll") for (int r = 1; r < 32; ++r) mx = fmaxf(mx, pv[r]); \
        mx = xhalf_max(mx); \
        if (!rowsel) mx = AT_NEG; \
        if (!__all(mx - mrow <= 8.0f)) { \
            const float mnew = fmaxf(mrow, mx), alpha = __builtin_amdgcn_exp2f(mrow - mnew); \
            mrow = mnew; lrow *= alpha; \
            _Pragma("unroll") for (int c = 0; c < 4; ++c) o[c] *= alpha; \
        } \
        { const float msub = rowsel ? mrow : -AT_NEG;                      \
          _Pragma("unroll") for (int r = 0; r < 32; ++r) pv[r] = __builtin_amdgcn_exp2f(pv[r] - msub); } \
        } \
        unsigned pwd[16]; float ps0 = 0.f, ps1 = 0.f;                      \
        _Pragma("unroll") for (int i = 0; i < 16; i += 2) { pwd[i] = cvtpk(pv[2 * i], pv[2 * i + 1]); pwd[i + 1] = cvtpk(pv[2 * i + 2], pv[2 * i + 3]); \
            ps0 = __builtin_amdgcn_fdot2_f32_bf16(__builtin_bit_cast(bf16x2_at, pwd[i]), __builtin_bit_cast(bf16x2_at, 0x3f803f80u), ps0, false); \
            ps1 = __builtin_amdgcn_fdot2_f32_bf16(__builtin_bit_cast(bf16x2_at, pwd[i + 1]), __builtin_bit_cast(bf16x2_at, 0x3f803f80u), ps1, false); } \
        lrow += xhalf_sum(ps0 + ps1); \
        bf16x8_t pf[4]; \
        _Pragma("unroll") for (int ks = 0; ks < 4; ++ks) { const v4u pw = {pwd[4 * ks], pwd[4 * ks + 1], pwd[4 * ks + 2], pwd[4 * ks + 3]}; pf[ks] = __builtin_bit_cast(bf16x8_t, pw); } \
        __builtin_amdgcn_sched_barrier(0); \
        vtr_wait(vr0, vr1); \
        _Pragma("unroll") for (int c = 0; c < 4; ++c) o[c] = __builtin_amdgcn_mfma_f32_32x32x16_bf16(vcat(vr0[2 * c], vr0[2 * c + 1]), pf[0], o[c], 0, 0, 0); \
        s16x4_t vr2[8], vr3[8]; \
        vtr_issue<VOFF + 8192>(vr2, vad); \
        __builtin_amdgcn_sched_barrier(0); \
        _Pragma("unroll") for (int c = 0; c < 4; ++c) o[c] = __builtin_amdgcn_mfma_f32_32x32x16_bf16(vcat(vr1[2 * c], vr1[2 * c + 1]), pf[1], o[c], 0, 0, 0); \
        vtr_issue<VOFF + 12288>(vr3, vad); \
        __builtin_amdgcn_sched_barrier(0); \
        vtr_wait(vr2, vr3); \
        _Pragma("unroll") for (int c = 0; c < 4; ++c) o[c] = __builtin_amdgcn_mfma_f32_32x32x16_bf16(vcat(vr2[2 * c], vr2[2 * c + 1]), pf[2], o[c], 0, 0, 0); \
        _Pragma("unroll") for (int c = 0; c < 4; ++c) o[c] = __builtin_amdgcn_mfma_f32_32x32x16_bf16(vcat(vr3[2 * c], vr3[2 * c + 1]), pf[3], o[c], 0, 0, 0); \
        __builtin_amdgcn_sched_barrier(0); \
    } while (0)
    int tfar; { const int q_ = nown * 256 + r0 - 176; tfar = q_ < 0 ? 0 : ((q_ >> 6) + 1); tfar &= ~1; if (tfar > nt_w) tfar = nt_w; }
    for (int it2 = 0; it2 < tfar; it2 += 2) { ATTN_TILE(it2, 0, true); ATTN_TILE(it2 + 1, 1, true); }
    for (int it2 = tfar; it2 < nt_w; it2 += 2) { ATTN_TILE(it2, 0, false); ATTN_TILE(it2 + 1, 1, false); }
#undef ATTN_TILE
    const float inv = 1.f / lrow;
    bf16* op = Og + (size_t)(b * SEQ + nown * 256 + rq) * 1024 + h * HD + 8 * hi;
#pragma unroll
    for (int c = 0; c < 4; ++c)
#pragma unroll
        for (int k = 0; k < 2; ++k) {
            unsigned ax = cvtpk(o[c][8 * k + 0] * inv, o[c][8 * k + 1] * inv), ay = cvtpk(o[c][8 * k + 2] * inv, o[c][8 * k + 3] * inv);
            unsigned bx = cvtpk(o[c][8 * k + 4] * inv, o[c][8 * k + 5] * inv), by = cvtpk(o[c][8 * k + 6] * inv, o[c][8 * k + 7] * inv);
            asm volatile("v_nop\n\tv_nop\n\tv_permlane32_swap_b32 %0, %1" : "+v"(ax), "+v"(bx));
            asm volatile("v_nop\n\tv_nop\n\tv_permlane32_swap_b32 %0, %1" : "+v"(ay), "+v"(by));
            const v4u w = {ax, ay, bx, by};
            *(v4u*)(op + 32 * c + 16 * k) = w; }
    asm volatile("s_waitcnt vmcnt(0)" ::: "memory");
    {
        const bool conv = l + 1 < DEPTH;
        LAS float* scr = (LAS float*)(C.lds + AT_CONV + wq * TR_WAVE_BYTES);
        LAS float* gtab = (LAS float*)(C.lds + AT_GAIN);
        if (conv && nt_w < ntiles) {
            const int t = wq * 64 + lane;
#pragma unroll
            for (int j = 0; j < 2; ++j) { const float* g = (j ? C.in[17] : C.in[1]) + (size_t)(l + 1) * D_MODEL;
#pragma unroll
                for (int u = 0; u < 2; ++u) *(LAS f4_t*)(gtab + j * D_MODEL + 8 * t + 4 * u) = *(const f4_t*)(g + 8 * t + 4 * u); }
            asm volatile("s_waitcnt vmcnt(0) lgkmcnt(0)" ::: "memory");
        }
        const int sbase = (bh * 2 + half) * 1024 + 240 * ii - 16 * ii * (ii - 1) + wq;
        f4_t va[16], vb[16];
#pragma unroll
        for (int i = 0; i < 16; ++i) { va[i] = (f4_t){0.f, 0.f, 0.f, 0.f}; vb[i] = va[i]; }
        int ra = -1, rb = -1, aft_a = 0, aft_b = 0;
#define AT_IDLE_STEP(IT, VX, RX, AFX, AFY) do { const int it_ = (IT); \
            __builtin_amdgcn_s_barrier(); asm volatile("" ::: "memory"); \
            if (it_ + 1 < ntiles) { attn_stage(C, Kg, Vg, b, h, (it_ + 1) * 64, (it_ + 1) & 1, true); AFX += 8; AFY += 8; } \
            int adma = 0; \
            if (conv) { int ll = l + 1, ln = lane; asm volatile("" : "+s"(ll), "+v"(ln));     \
                if (RX >= 0) { wait_vm_le(AFX); TI_TIE(VX); const ItemP P = item_params(C, ll, RX); ti_finish_reg(VX, P, gtab, (LAS unsigned char*)scr, ln); AFY += 8; adma += 8; } \
                const int slot = sbase + (it_ - TA) * 4, s64 = (slot * 37) & 63; RX = s64 < 35 ? (slot >> 6) * 35 + s64 : -1; \
                if (RX >= 0) { const ItemP P = item_params(C, ll, RX); ti_load_asm(VX, P, ln); AFX = 0; AFY += 16; adma += 16; } } \
            wait_vm_le(adma); } while (0)
        for (int it = nt_w; it < ntiles; it += 2) { AT_IDLE_STEP(it, va, ra, aft_a, aft_b); AT_IDLE_STEP(it + 1, vb, rb, aft_b, aft_a); }
#undef AT_IDLE_STEP
        asm volatile("s_waitcnt vmcnt(0)" ::: "memory");
        if (ra >= 0) { TI_TIE(va); const ItemP P = item_params(C, l + 1, ra); ti_finish_reg(va, P, gtab, (LAS unsigned char*)scr, lane); }
        if (rb >= 0) { TI_TIE(vb); const ItemP P = item_params(C, l + 1, rb); ti_finish_reg(vb, P, gtab, (LAS unsigned char*)scr, lane); }
    }
    asm volatile("s_waitcnt vmcnt(0)" ::: "memory");
    __builtin_amdgcn_s_barrier();
}
constexpr int LR_PITCH = 272;
constexpr size_t CTL_LRUF = 2 * MiB;
__device__ __forceinline__ float gelu_t(float x) { return x * __builtin_amdgcn_rcpf(1.f + __builtin_amdgcn_exp2f(-2.3022081984f * x * (1.f + 0.044715f * x * x))); }
constexpr size_t WS_LHG = WS_END, WS_LPG = WS_END + (size_t)M_TOK * LRU_W * 4, WS_END2 = WS_LPG + (size_t)M_TOK * LRU_W * 4;
__device__ __forceinline__ void lru_local(Ctx& C, int l) {
    relaunder(C);
    const int bid = C.bid, b = bid >> 7, g = (bid >> 4) & 7, c = bid & 15, tid = C.tid, lane = C.lane, wave = C.wave;
    const bf16* XR = C.seg(SEG_XR); const bf16* GR = C.seg(SEG_GR);
    unsigned* HP = (unsigned*)(C.ws + WS_LHG);
    const float* cw = C.in[6] + (size_t)l * 4 * LRU_W; const float* cb = C.in[7] + (size_t)l * LRU_W;
    const float* wa = C.in[8] + (size_t)l * LRU_G * LRU_BW * LRU_BW; const float* ba = C.in[9] + (size_t)l * LRU_W;
    const float* wx = C.in[10] + (size_t)l * LRU_G * LRU_BW * LRU_BW; const float* bx = C.in[11] + (size_t)l * LRU_W; const float* lam = C.in[12] + (size_t)l * LRU_W;
    unsigned long long* sums = (unsigned long long*)(C.ws + WS_LRUS) + (size_t)l * 256 * 128;
    unsigned* flags = (unsigned*)(C.ws + WS_CTL + CTL_LRUF) + (size_t)l * 256 * 64;
    const int tok0 = b * SEQ + c * 256;
    {
        const int ck = tid & 15, ch0 = g * 128 + ck * 8;
        float w[4][8], bb[8];
#pragma unroll
        for (int k = 0; k < 4; ++k) { const f32x4_t a0 = *(const f32x4_t*)(cw + k * LRU_W + ch0), a1 = *(const f32x4_t*)(cw + k * LRU_W + ch0 + 4);
#pragma unroll
            for (int j = 0; j < 4; ++j) { w[k][j] = a0[j]; w[k][4 + j] = a1[j]; } }
        { const f32x4_t a0 = *(const f32x4_t*)(cb + ch0), a1 = *(const f32x4_t*)(cb + ch0 + 4);
#pragma unroll
          for (int j = 0; j < 4; ++j) { bb[j] = a0[j]; bb[4 + j] = a1[j]; } }
#pragma unroll 2
        for (int i = 0; i < 8; ++i) {
            const int t = (tid >> 4) + 32 * i;
            float acc[8];
#pragma unroll
            for (int j = 0; j < 8; ++j) acc[j] = bb[j];
#pragma unroll
            for (int k = 0; k < 4; ++k) { const int ts = c * 256 + t - 3 + k;
                if (ts >= 0) { const v4u v = *(const v4u*)(XR + (size_t)(b * SEQ + ts) * 1024 + ch0);
                    acc[0] += w[k][0] * bflo(v.x); acc[1] += w[k][1] * bfhi(v.x); acc[2] += w[k][2] * bflo(v.y); acc[3] += w[k][3] * bfhi(v.y);
                    acc[4] += w[k][4] * bflo(v.z); acc[5] += w[k][5] * bfhi(v.z); acc[6] += w[k][6] * bflo(v.w); acc[7] += w[k][7] * bfhi(v.w); } }
            const v4u o = {cvtpk(acc[0], acc[1]), cvtpk(acc[2], acc[3]), cvtpk(acc[4], acc[5]), cvtpk(acc[6], acc[7])};
            *(LAS v4u*)(C.lds + t * LR_PITCH + ck * 16) = o;
        }
    }
    asm volatile("s_waitcnt vmcnt(0) lgkmcnt(0)" ::: "memory"); __builtin_amdgcn_s_barrier(); asm volatile("" ::: "memory");
    const int chn = wave * 16 + (lane & 15);
    const int n16 = lane & 15, q4 = lane >> 4, chg = g * 128 + chn;
    bf16x8_t fa[4], fx[4];
#pragma unroll
    for (int ks = 0; ks < 4; ++ks) { float va[8], vx[8];
#pragma unroll
        for (int j = 0; j < 8; ++j) { const size_t o = ((size_t)g * 128 + 32 * ks + 8 * q4 + j) * 128 + wave * 16 + n16; va[j] = wa[o]; vx[j] = wx[o]; }
        const v4u pa = {cvtpk(va[0], va[1]), cvtpk(va[2], va[3]), cvtpk(va[4], va[5]), cvtpk(va[6], va[7])}, px = {cvtpk(vx[0], vx[1]), cvtpk(vx[2], vx[3]), cvtpk(vx[4], vx[5]), cvtpk(vx[6], vx[7])};
        fa[ks] = __builtin_bit_cast(bf16x8_t, pa); fx[ks] = __builtin_bit_cast(bf16x8_t, px); }
    const float bav = ba[chg], bxv = bx[chg];
    float spv; { const float nl = -lam[chg]; spv = fmaxf(nl, 0.f) + log1pf(expf(-fabsf(nl))); }
    const float m8sp = -8.0f * spv * 1.4426950408889634f;
    float carry = 0.f, Ptot = 1.f;
#pragma unroll 2
    for (int tt = 0; tt < 16; ++tt) {
        f32x4_t ar = {0.f, 0.f, 0.f, 0.f}, ai = {0.f, 0.f, 0.f, 0.f};
#pragma unroll
        for (int ks = 0; ks < 4; ++ks) { const bf16x8_t af = *(LAS const bf16x8_t*)(C.lds + (16 * tt + n16) * LR_PITCH + (32 * ks + 8 * q4) * 2);
            ar = __builtin_amdgcn_mfma_f32_16x16x32_bf16(af, fa[ks], ar, 0, 0, 0); ai = __builtin_amdgcn_mfma_f32_16x16x32_bf16(af, fx[ks], ai, 0, 0, 0); }
        float P[4], H[4], gl[4];
#pragma unroll
        for (int i = 0; i < 4; ++i) gl[i] = bf2f(GR[(size_t)(tok0 + 16 * tt + 4 * q4 + i) * 1024 + chg]);
#pragma unroll
        for (int i = 0; i < 4; ++i) {
            const int t = 16 * tt + 4 * q4 + i;
            const float xcv = bf2f(*(LAS const unsigned short*)(C.lds + t * LR_PITCH + chn * 2));
            const float r = pg8::sigm(ar[i] + bav), ig = pg8::sigm(ai[i] + bxv);
            const float l2a = m8sp * r;
            const float a = __builtin_amdgcn_exp2f(l2a);
            const float y = 1.3862943611198906f * l2a;
            const float ser = -y * (1.f + y * (0.5f + y * (0.16666667f + y * (0.041666668f + y * 0.008333334f))));
            const float big = 1.f - a * a;
            const float om = y > -0.25f ? ser : big;
            const float u = __builtin_amdgcn_sqrtf(om) * ig * xcv;
            if (i == 0) { P[0] = a; H[0] = u; } else { P[i] = a * P[i - 1]; H[i] = a * H[i - 1] + u; }
        }
        float Pq[4], Hq[4];
#pragma unroll
        for (int qq = 0; qq < 4; ++qq) { Pq[qq] = bperm(P[3], n16 + 16 * qq); Hq[qq] = bperm(H[3], n16 + 16 * qq); }
        const float c0 = carry, c1 = Hq[0] + Pq[0] * c0, c2 = Hq[1] + Pq[1] * c1, c3 = Hq[2] + Pq[2] * c2;
        const float p0 = Ptot, p1 = p0 * Pq[0], p2 = p1 * Pq[1], p3 = p2 * Pq[2];
        carry = Hq[3] + Pq[3] * c3; Ptot = p3 * Pq[3];
        const float cin = q4 == 0 ? c0 : (q4 == 1 ? c1 : (q4 == 2 ? c2 : c3)), pin = q4 == 0 ? p0 : (q4 == 1 ? p1 : (q4 == 2 ? p2 : p3));
#pragma unroll
        for (int i = 0; i < 4; ++i) { const size_t o = (size_t)(tok0 + 16 * tt + 4 * q4 + i) * 1024 + chg; const float ge = gelu_t(gl[i]);
            HP[o] = cvtpk((H[i] + P[i] * cin) * ge, (P[i] * pin) * ge); }
    }
    if (q4 == 0) __hip_atomic_store(sums + (size_t)bid * 128 + chn, ((unsigned long long)__builtin_bit_cast(unsigned, carry) << 32) | (unsigned long long)__builtin_bit_cast(unsigned, Ptot), __ATOMIC_RELAXED, __HIP_MEMORY_SCOPE_AGENT);
    asm volatile("s_waitcnt vmcnt(0) lgkmcnt(0)" ::: "memory");
    __builtin_amdgcn_s_barrier();
    if (tid == 0) __hip_atomic_store(flags + (size_t)bid * 64, 1u, __ATOMIC_RELAXED, __HIP_MEMORY_SCOPE_AGENT);
}
__device__ __forceinline__ void lru_fix(Ctx& C, int l) {
    relaunder(C);
    const int bid = C.bid, b = bid >> 7, g = (bid >> 4) & 7, c = bid & 15, tid = C.tid, lane = C.lane, wave = C.wave;
    const unsigned* HP = (const unsigned*)(C.ws + WS_LHG); bf16* OB = C.abc(1);
    const unsigned long long* sums = (const unsigned long long*)(C.ws + WS_LRUS) + (size_t)l * 256 * 128;
    const unsigned* flags = (const unsigned*)(C.ws + WS_CTL + CTL_LRUF) + (size_t)l * 256 * 64;
    LAS float* cl = (LAS float*)C.lds;
    if (wave == 0) {
        if (lane < c) { const unsigned* f = flags + (size_t)((bid & ~15) + lane) * 64; unsigned spins = 0;
            while (__hip_atomic_load(f, __ATOMIC_RELAXED, __HIP_MEMORY_SCOPE_AGENT) == 0u) { __builtin_amdgcn_s_sleep(2); if (++spins > (1u << 22)) break; } }
        __builtin_amdgcn_fence(__ATOMIC_ACQUIRE, "agent");
        asm volatile("s_waitcnt vmcnt(0)" ::: "memory");
    }
    asm volatile("s_waitcnt vmcnt(0) lgkmcnt(0)" ::: "memory"); __builtin_amdgcn_s_barrier(); asm volatile("" ::: "memory");
    if (tid < 128) { float carry = 0.f;
        for (int cc = 0; cc < c; ++cc) { const unsigned long long v = __hip_atomic_load(sums + (size_t)((bid & ~15) + cc) * 128 + tid, __ATOMIC_RELAXED, __HIP_MEMORY_SCOPE_AGENT);
            const float A = __builtin_bit_cast(float, (unsigned)v), H = __builtin_bit_cast(float, (unsigned)(v >> 32)); carry = H + A * carry; }
        cl[tid] = carry; }
    asm volatile("s_waitcnt vmcnt(0) lgkmcnt(0)" ::: "memory"); __builtin_amdgcn_s_barrier(); asm volatile("" ::: "memory");
    const int ck = tid & 15; float cr[8];
#pragma unroll
    for (int j = 0; j < 8; ++j) cr[j] = cl[ck * 8 + j];
    const size_t base = (size_t)(b * SEQ + c * 256) * 1024 + g * 128 + ck * 8;
#pragma unroll 4
    for (int i = 0; i < 8; ++i) { const size_t o = base + (size_t)((tid >> 4) + 32 * i) * 1024;
        const v4u w0 = *(const v4u*)(HP + o), w1 = *(const v4u*)(HP + o + 4);
        const v4u r = {cvtpk(bflo(w0.x) + bfhi(w0.x) * cr[0], bflo(w0.y) + bfhi(w0.y) * cr[1]), cvtpk(bflo(w0.z) + bfhi(w0.z) * cr[2], bflo(w0.w) + bfhi(w0.w) * cr[3]),
                       cvtpk(bflo(w1.x) + bfhi(w1.x) * cr[4], bflo(w1.y) + bfhi(w1.y) * cr[5]), cvtpk(bflo(w1.z) + bfhi(w1.z) * cr[6], bflo(w1.w) + bfhi(w1.w) * cr[7])};
        *(v4u*)(OB + o) = r; }
    asm volatile("s_waitcnt vmcnt(0) lgkmcnt(0)" ::: "memory"); __builtin_amdgcn_s_barrier();
}
__device__ __forceinline__ void ph_shortconv(Ctx& C, int l) {
    relaunder(C);
    const bf16* SB = C.seg(SEG_SCB); const bf16* SCc = C.seg(SEG_SCC); const bf16* SX = C.seg(SEG_SCX); bf16* OC = C.abc(2);
    const float* cw = C.in[14] + (size_t)l * 3 * SC_W;
    const int ck = C.tid & 127, ch0 = ck * 8;
    float w[3][8];
#pragma unroll
    for (int k = 0; k < 3; ++k) { const f32x4_t a0 = *(const f32x4_t*)(cw + k * SC_W + ch0), a1 = *(const f32x4_t*)(cw + k * SC_W + ch0 + 4);
#pragma unroll
        for (int j = 0; j < 4; ++j) { w[k][j] = a0[j]; w[k][4 + j] = a1[j]; } }
    for (int i = 0; i < 8; ++i) {
        const int row = C.bid * 32 + (C.tid >> 7) + 4 * i, t = row & (SEQ - 1);
        float acc[8];
#pragma unroll
        for (int j = 0; j < 8; ++j) acc[j] = 0.f;
#pragma unroll
        for (int k = 0; k < 3; ++k) { if (t - 2 + k >= 0) { const size_t o = (size_t)(row - 2 + k) * 1024 + ch0; const v4u cv = *(const v4u*)(SCc + o), xv = *(const v4u*)(SX + o);
                acc[0] += w[k][0] * (bflo(cv.x) * bflo(xv.x)); acc[1] += w[k][1] * (bfhi(cv.x) * bfhi(xv.x)); acc[2] += w[k][2] * (bflo(cv.y) * bflo(xv.y)); acc[3] += w[k][3] * (bfhi(cv.y) * bfhi(xv.y));
                acc[4] += w[k][4] * (bflo(cv.z) * bflo(xv.z)); acc[5] += w[k][5] * (bfhi(cv.z) * bfhi(xv.z)); acc[6] += w[k][6] * (bflo(cv.w) * bflo(xv.w)); acc[7] += w[k][7] * (bfhi(cv.w) * bfhi(xv.w)); } }
        const size_t o = (size_t)row * 1024 + ch0; const v4u bv = *(const v4u*)(SB + o);
        const v4u r = {cvtpk(acc[0] * bflo(bv.x), acc[1] * bfhi(bv.x)), cvtpk(acc[2] * bflo(bv.y), acc[3] * bfhi(bv.y)), cvtpk(acc[4] * bflo(bv.z), acc[5] * bfhi(bv.z)), cvtpk(acc[6] * bflo(bv.w), acc[7] * bfhi(bv.w))};
        *(v4u*)(OC + o) = r;
    }
}
__device__ __forceinline__ void ph_mixers(Ctx& C, int l) {
    lru_local(C, l);
    ph_shortconv(C, l);
    asm volatile("s_waitcnt vmcnt(0) lgkmcnt(0)" ::: "memory"); __builtin_amdgcn_s_barrier();
    ph_attention(C, l);
    lru_fix(C, l);
}


#define XB_TMO      128
#define XB_XCNT(j)  (256  + 64 * (j))
#define XB_XSUB(j)  (1280 + 64 * (j))
#define XB_XGEN(j)  (2304 + 64 * (j))
#define XB_TOP      3328
#define XB_TOPGEN   3392
#define XCD_BAR_WORDS 3456
#define XB_SPIN_CAP (1u << 18)

__device__ __forceinline__ unsigned xb_ld(unsigned* p)              { return __hip_atomic_load(p, __ATOMIC_RELAXED, __HIP_MEMORY_SCOPE_AGENT); }
__device__ __forceinline__ unsigned xb_add(unsigned* p, unsigned v) { return __hip_atomic_fetch_add(p, v, __ATOMIC_RELAXED, __HIP_MEMORY_SCOPE_AGENT); }
__device__ __forceinline__ unsigned xb_xcc_id() { return (unsigned)__builtin_amdgcn_s_getreg((3 << 11) | 20) & 0xFu; }
#define XB_SPIN(cond, bar) do { unsigned _sp = 0; while (cond) { __builtin_amdgcn_s_sleep(1); \
    if ((++_sp & 255u) == 0u) { if (xb_ld(&(bar)[XB_TMO])) break; if (_sp > XB_SPIN_CAP) { atomicAdd(&(bar)[XB_TMO], 1u); break; } } } } while (0)

struct XcdBarrier {
    unsigned* bar; unsigned x;
    volatile LAS unsigned* st;
};

__device__ __forceinline__ XcdBarrier xcd_barrier_post(unsigned* bar, volatile LAS unsigned* st) {
    XcdBarrier b; b.bar = bar; b.x = xb_xcc_id(); b.st = st;
    if (threadIdx.x == 0) (void)xb_add(&bar[XB_XCNT(b.x)], 1u);
    return b;
}
__device__ __forceinline__ void xcd_barrier_complete(unsigned* bar, unsigned x, unsigned& nloc, unsigned& nx) {
    const unsigned G = gridDim.x * gridDim.y * gridDim.z;
    unsigned sum, cnt, mine, sp = 0u;
    for (;;) {
        sum = 0u; cnt = 0u; mine = 0u;
#pragma unroll
        for (unsigned j = 0; j < 16; ++j) { const unsigned c = xb_ld(&bar[XB_XCNT(j)]); sum += c; cnt += (c > 0u) ? 1u : 0u; mine = (j == x) ? c : mine; }
        if (sum == G) break;
        __builtin_amdgcn_s_sleep(1);
        if ((++sp & 255u) == 0u) { if (xb_ld(&bar[XB_TMO])) break; if (sp > XB_SPIN_CAP) { atomicAdd(&bar[XB_TMO], 1u); break; } }
    }
    nloc = mine > 0u ? mine : 1u; nx = cnt > 0u ? cnt : 1u;
}

__device__ __forceinline__ void xcd_barrier(const XcdBarrier& b) {
    asm volatile("s_waitcnt vmcnt(0)" ::: "memory");
    __syncthreads();
    if (threadIdx.x == 0) {
        unsigned* bar = b.bar;
        __builtin_amdgcn_s_waitcnt(0);
        unsigned nloc = b.st[0], nx = b.st[1];
        if (nloc == 0u) { xcd_barrier_complete(bar, b.x, nloc, nx); b.st[0] = nloc; b.st[1] = nx; }
        const unsigned old = xb_add(&bar[XB_XSUB(b.x)], 1u);
        const unsigned gen = old / nloc;
        if (old + 1u == (gen + 1u) * nloc) {
            __builtin_amdgcn_fence(__ATOMIC_RELEASE, "agent");
            asm volatile("s_waitcnt vmcnt(0)" ::: "memory");
            const unsigned og = xb_add(&bar[XB_TOP], 1u);
            const unsigned tg = og / nx;
            if (og + 1u == (tg + 1u) * nx) xb_add(&bar[XB_TOPGEN], 1u);
            else XB_SPIN(xb_ld(&bar[XB_TOPGEN]) == tg, bar);
            __builtin_amdgcn_fence(__ATOMIC_ACQUIRE, "agent");
            xb_add(&bar[XB_XGEN(b.x)], 1u);
            asm volatile("s_waitcnt vmcnt(0)" ::: "memory");
        } else {
            XB_SPIN(xb_ld(&bar[XB_XGEN(b.x)]) == gen, bar);
            __builtin_amdgcn_fence(__ATOMIC_ACQUIRE, "agent");
            asm volatile("s_waitcnt vmcnt(0)" ::: "memory");
        }
    }
    __syncthreads();
}


constexpr size_t CTL_BAR = 65536;
__device__ __forceinline__ void make_ctx(Ctx& C, const Args& a, unsigned char* lds) {
    C.lds = (LAS unsigned char*)lds; C.tid = threadIdx.x; C.lane = C.tid & 63; C.wave = __builtin_amdgcn_readfirstlane(C.tid >> 6); C.G = gridDim.x; C.bid = blockIdx.x;
#pragma unroll
    for (int i = 0; i < 21; ++i) C.in[i] = a.in[i];
    C.out = a.out; C.ws = a.ws;
}
__global__ void __launch_bounds__(512, 2) mega_fwd(Args a) {
    extern __shared__ __attribute__((aligned(16))) unsigned char lds[];
    Ctx C; make_ctx(C, a, lds);
    volatile LAS unsigned* MISC = (volatile LAS unsigned*)(C.lds + MISC_OFF);
    if (C.tid < 64) MISC[C.tid] = 0u;
    __syncthreads();
    XcdBarrier bar = xcd_barrier_post((unsigned*)(a.ws + WS_CTL + CTL_BAR), MISC + 8);
#define GRID_BAR() do { unsigned* bp_ = (unsigned*)(a.ws + WS_CTL + CTL_BAR); unsigned x_ = bar.x; asm volatile("" : "+s"(bp_), "+s"(x_)); bar.bar = bp_; bar.x = x_; xcd_barrier(bar); } while (0)
    ph_prologue(C);
    GRID_BAR();
    for (int l = 0; l < DEPTH; ++l) {
        ph_inproj(C, l);
        GRID_BAR();
        ph_mixers(C, l);
        GRID_BAR();
        ph_merge(C, l);
        GRID_BAR();
        ph_out(C, l);
        GRID_BAR();
        ph_up(C, l);
        GRID_BAR();
        ph_down(C, l);
        if (l + 1 < DEPTH) GRID_BAR();
    }
}

extern "C" void kernel_launch(void* const* d_in, const int* in_sizes, int n_in, void* d_out, int out_size, void* d_ws, size_t ws_size, hipStream_t stream) {
    static int grid = 0;
    if (grid == 0) {
        if (n_in != 21 || in_sizes[0] != M_TOK * D_MODEL || out_size != M_TOK * D_MODEL || ws_size < WS_END2) { fprintf(stderr, "kernel_launch: unexpected shapes (n_in %d, ws %zu < %zu); nothing launched\n", n_in, ws_size, (size_t)WS_END); grid = -1; return; }
        int dev = 0, cus = 0, per_cu = 0;
        if (hipGetDevice(&dev) != hipSuccess || hipDeviceGetAttribute(&cus, hipDeviceAttributeMultiprocessorCount, dev) != hipSuccess) { fprintf(stderr, "kernel_launch: device query failed\n"); grid = -1; return; }
        if (hipFuncSetAttribute((const void*)mega_fwd, hipFuncAttributeMaxDynamicSharedMemorySize, LDS_BYTES) != hipSuccess) { fprintf(stderr, "kernel_launch: hipFuncSetAttribute failed\n"); grid = -1; return; }
        if (hipOccupancyMaxActiveBlocksPerMultiprocessor(&per_cu, (const void*)mega_fwd, NWAVES * 64, LDS_BYTES) != hipSuccess || per_cu < 1) fprintf(stderr, "kernel_launch: note: occupancy query reports %d workgroups per CU\n", per_cu);
        (void)hipGetLastError();
        if (cus != 256) fprintf(stderr, "kernel_launch: note: %d CUs; this kernel is laid out for 256 workgroups (one per CU of a 256-CU device)\n", cus);
        grid = 256;
    }
    if (grid < 0) return;
    if (hipMemsetAsync((char*)d_ws + WS_CTL, 0, CTL_ZERO_BYTES, stream) != hipSuccess) { fprintf(stderr, "kernel_launch: memset failed\n"); return; }
    Args a{};
    for (int i = 0; i < 21; ++i) a.in[i] = (const float*)d_in[i];
    a.out = (float*)d_out; a.ws = (unsigned char*)d_ws; a.l = 0; a.pad = 0;
    hipLaunchKernelGGL(mega_fwd, dim3(grid), dim3(NWAVES * 64), LDS_BYTES, stream, a);
    const hipError_t le = hipPeekAtLastError();
    if (le != hipSuccess) fprintf(stderr, "kernel_launch: launch failed: %s\n", hipGetErrorName(le));
}
```
